# Optimizing an MI355X kernel written in HIP

```python
import math
import jax
import jax.numpy as jnp
from jax import lax
import numpy as np

D_MODEL = 2048
BATCH = 2
SEQ = 8192
DEPTH = 2

CTX_LEN = 256
GRID_W = 64

ATT_WIDTH = D_MODEL // 2
CONV_WIDTH = D_MODEL // 4
HGRN_WIDTH = D_MODEL // 4
MIX_WIDTH = ATT_WIDTH + CONV_WIDTH + HGRN_WIDTH

ATT_HEAD_DIM = 64
ATT_HEADS = ATT_WIDTH // (2 * ATT_HEAD_DIM)
ROPE_THETA = 10000.0
Q_BLOCK = 128

CONV_K = 3

HGRN_HEAD_DIM = 128
HGRN_HEADS = HGRN_WIDTH // HGRN_HEAD_DIM
HGRN_CHUNK = 64

N_EXPERTS = 16
EXPERT_FF = D_MODEL // 2
EC_CAPACITY_FACTOR = 2

PROJ_SIZES = (ATT_WIDTH,) * 3 + (CONV_WIDTH,) * 3 + (HGRN_WIDTH,) * 5
PROJ_WIDTH = sum(PROJ_SIZES)

ALPHA = (2.0 * DEPTH) ** 0.25
BETA = (8.0 * DEPTH) ** -0.25
EPS = 1e-6

kernel_name = 'hybrid_diffusion_diffattn_conv_hgrn2_ecmoe'


def layer_norm(x, w, b):
    xf = x.astype(jnp.float32)
    mu = jnp.mean(xf, axis=-1, keepdims=True)
    var = jnp.mean(jnp.square(xf - mu), axis=-1, keepdims=True)
    return ((xf - mu) * lax.rsqrt(var + EPS) * w + b).astype(x.dtype)


def rms_norm(x, w):
    xf = x.astype(jnp.float32)
    return (xf * lax.rsqrt(jnp.mean(jnp.square(xf), axis=-1, keepdims=True) + EPS) * w).astype(x.dtype)


def split_proj(p):
    offsets = np.cumsum(PROJ_SIZES)[:-1].tolist()
    return jnp.split(p, offsets, axis=-1)


def axial_rope(t, row, col):
    half = ATT_HEAD_DIM // 2
    nf = half // 2
    inv = ROPE_THETA ** (-jnp.arange(nf, dtype=jnp.float32) / nf)
    tf = t.astype(jnp.float32)

    def rot(part, pos):
        ang = pos[:, None] * inv
        cs = jnp.cos(ang)[:, None, None, :]
        sn = jnp.sin(ang)[:, None, None, :]
        p1, p2 = part[..., :nf], part[..., nf:]
        return jnp.concatenate([p1 * cs - p2 * sn, p2 * cs + p1 * sn], axis=-1)

    out = jnp.concatenate([rot(tf[..., :half], row), rot(tf[..., half:], col)], axis=-1)
    return out.astype(t.dtype)


def diff_attn(q, k, v, lam):
    s = jnp.einsum('bqhsd,bkhsd->bhsqk', q, k).astype(jnp.float32)
    p = jax.nn.softmax(s, axis=-1)
    a = p[:, :, 0] - lam * p[:, :, 1]
    return jnp.einsum('bhqk,bkhe->bqhe', a.astype(v.dtype), v)


def diff_attn_latent(q, k_all, v_all, lam):
    b, n = q.shape[:2]
    nb = n // Q_BLOCK
    qb = jnp.moveaxis(q.reshape(b, nb, Q_BLOCK, ATT_HEADS, 2, ATT_HEAD_DIM), 1, 0)
    ob = lax.map(lambda blk: diff_attn(blk, k_all, v_all, lam), qb)
    return jnp.moveaxis(ob, 0, 1).reshape(b, n, ATT_HEADS, 2 * ATT_HEAD_DIM)


def centred_conv(u, w):
    up = jnp.pad(u, ((0, 0), (1, 1), (0, 0)))
    return up[:, :-2] * w[0] + up[:, 1:-1] * w[1] + up[:, 2:] * w[2]


def forget_gate(z, lb):
    zf = z.astype(jnp.float32)
    logf = jnp.logaddexp(jnp.log(lb), jnp.log1p(-lb) + jax.nn.log_sigmoid(zf))
    key_in = (1.0 - lb) * jax.nn.sigmoid(-zf)
    return logf, key_in


def hgrn_chunk_scan(q, k, v, logf, s0):
    b, l, h, _ = q.shape
    nc = l // HGRN_CHUNK

    def to_chunks(t):
        return t.reshape(b, nc, HGRN_CHUNK, h, t.shape[-1]).transpose(1, 0, 3, 2, 4)

    mask = jnp.tril(jnp.ones((HGRN_CHUNK, HGRN_CHUNK), dtype=bool))[:, :, None]

    def step(s, inp):
        qc, kc, vc, lc = inp
        a = jnp.cumsum(lc, axis=-2)
        inter = jnp.einsum('bhid,bhde->bhie', qc * jnp.exp(a), s)
        rel = jnp.where(mask, a[:, :, :, None, :] - a[:, :, None, :, :], -jnp.inf)
        scores = jnp.einsum('bhid,bhjd,bhijd->bhij', qc, kc, jnp.exp(rel))
        intra = jnp.einsum('bhij,bhje->bhie', scores, vc)
        a_last = a[:, :, -1:, :]
        s_new = jnp.exp(a_last[:, :, 0, :])[..., None] * s + jnp.einsum('bhjd,bhje->bhde', kc * jnp.exp(a_last - a), vc)
        return s_new, inter + intra

    s_fin, o = lax.scan(step, s0, (to_chunks(q), to_chunks(k), to_chunks(v), to_chunks(logf)))
    o = o.transpose(1, 0, 3, 2, 4).reshape(b, l, h, v.shape[-1])
    return o, s_fin


def hgrn_direction(ctx_in, lat_in, reverse):
    flip = (lambda t: jnp.flip(t, axis=1)) if reverse else (lambda t: t)
    qc = ctx_in[0]
    s0 = jnp.zeros((qc.shape[0], HGRN_HEADS, HGRN_HEAD_DIM, HGRN_HEAD_DIM), jnp.float32)
    o_c, s_c = hgrn_chunk_scan(*[flip(t) for t in ctx_in], s0)
    o_l, _ = hgrn_chunk_scan(*[flip(t) for t in lat_in], s_c)
    return flip(o_c), flip(o_l)


def expert_choice_moe(h, w_router, w_gate, w_up, w_down):
    b, n, _ = h.shape
    cap = EC_CAPACITY_FACTOR * n // N_EXPERTS
    aff = jax.nn.softmax((h @ w_router).astype(jnp.float32), axis=-1)
    gates, idx = lax.top_k(jnp.swapaxes(aff, 1, 2), cap)
    xg = jax.vmap(lambda hb, ib: hb[ib])(h, idx)
    a = jnp.einsum('becd,edf->becf', xg, w_gate)
    u = jnp.einsum('becd,edf->becf', xg, w_up)
    y = jnp.einsum('becf,efd->becd', jax.nn.silu(a) * u, w_down) * gates[..., None].astype(h.dtype)
    bidx = jnp.arange(b)[:, None, None]
    return jnp.zeros_like(h).at[bidx, idx].add(y)


def hybrid_mixer(h, hc, w_in, w_conv, lambda_qk, lambda_init, subln_w, lb_fwd, lb_bwd, hgrn_norm_w,
                 w_out, row, col, need_ctx):
    b, n, _ = h.shape
    m = hc.shape[1]
    aq, ak, av, cx, cb, cc, gq, gi, gg, gff, gfb = split_proj(h @ w_in)
    aqc, akc, avc, cxc, cbc, ccc, gqc, gic, ggc, gffc, gfbc = split_proj(hc @ w_in)

    qk_heads = lambda t: t.reshape(t.shape[0], t.shape[1], ATT_HEADS, 2, ATT_HEAD_DIM)
    v_heads = lambda t: t.reshape(t.shape[0], t.shape[1], ATT_HEADS, 2 * ATT_HEAD_DIM)
    scale = ATT_HEAD_DIM ** -0.5
    lq = lambda_qk.astype(jnp.float32)
    lam = jnp.exp(jnp.sum(lq[0] * lq[1])) - jnp.exp(jnp.sum(lq[2] * lq[3])) + lambda_init
    q = axial_rope(qk_heads(aq), row, col) * scale
    k = axial_rope(qk_heads(ak), row, col)
    kc = qk_heads(akc)
    vc = v_heads(avc)
    k_all = jnp.concatenate([k, kc], axis=1)
    v_all = jnp.concatenate([v_heads(av), vc], axis=1)
    att = rms_norm(diff_attn_latent(q, k_all, v_all, lam), subln_w) * (1.0 - lambda_init)

    conv = cb * centred_conv(cc * cx, w_conv)

    gh = lambda t: t.reshape(t.shape[0], t.shape[1], HGRN_HEADS, HGRN_HEAD_DIM)
    lbf = lb_fwd.reshape(HGRN_HEADS, HGRN_HEAD_DIM)
    lbb = lb_bwd.reshape(HGRN_HEADS, HGRN_HEAD_DIM)
    lf_f, k_f = forget_gate(gh(gff), lbf)
    lf_b, k_b = forget_gate(gh(gfb), lbb)
    lf_fc, k_fc = forget_gate(gh(gffc), lbf)
    lf_bc, k_bc = forget_gate(gh(gfbc), lbb)
    q_l, v_l = gh(gq).astype(jnp.float32), gh(gi).astype(jnp.float32)
    q_c, v_c = gh(gqc).astype(jnp.float32), gh(gic).astype(jnp.float32)
    of_c, of_l = hgrn_direction((q_c, k_fc, v_c, lf_fc), (q_l, k_f, v_l, lf_f), reverse=False)
    ob_c, ob_l = hgrn_direction((q_c, k_bc, v_c, lf_bc), (q_l, k_b, v_l, lf_b), reverse=True)
    rec = rms_norm(of_l + ob_l, hgrn_norm_w) * jax.nn.silu(gh(gg).astype(jnp.float32))

    y = jnp.concatenate([att.reshape(b, n, ATT_WIDTH), conv,
                         rec.reshape(b, n, HGRN_WIDTH).astype(h.dtype)], axis=-1) @ w_out
    if not need_ctx:
        return y, None

    att_c = rms_norm(diff_attn(qk_heads(aqc) * scale, kc, vc, lam), subln_w) * (1.0 - lambda_init)
    conv_c = cbc * centred_conv(ccc * cxc, w_conv)
    rec_c = rms_norm(of_c + ob_c, hgrn_norm_w) * jax.nn.silu(gh(ggc).astype(jnp.float32))
    y_c = jnp.concatenate([att_c.reshape(b, m, ATT_WIDTH), conv_c,
                           rec_c.reshape(b, m, HGRN_WIDTH).astype(hc.dtype)], axis=-1) @ w_out
    return y, y_c


def setup_inputs(seed: int = 0) -> dict:
    key = jax.random.key(seed)
    ks = jax.random.split(key, 20)
    d = D_MODEL

    def nrm(k, shape, s):
        return jax.random.normal(k, shape, jnp.float32) * s

    return {
        'x': nrm(ks[0], (BATCH, SEQ, d), 1.0),
        'c': nrm(ks[1], (BATCH, d), 1.0),
        'ctx': nrm(ks[2], (BATCH, CTX_LEN, d), 1.0),
        'c_ctx': nrm(ks[3], (d,), 1.0),
        'w_mod': nrm(ks[4], (DEPTH, d, 6 * d), 0.5 * d ** -0.5),
        'b_mod': nrm(ks[5], (DEPTH, 6 * d), 0.02),
        'w_in': nrm(ks[6], (DEPTH, d, PROJ_WIDTH), d ** -0.5),
        'w_conv': nrm(ks[7], (DEPTH, CONV_K, CONV_WIDTH), CONV_K ** -0.5),
        'lambda_qk': nrm(ks[8], (DEPTH, 4, ATT_HEAD_DIM), 0.1),
        'subln_w': 1.0 + nrm(ks[9], (DEPTH, 2 * ATT_HEAD_DIM), 0.02),
        'hgrn_lb_logits': nrm(ks[10], (2, DEPTH, HGRN_WIDTH), 0.1),
        'hgrn_norm_w': 1.0 + nrm(ks[11], (DEPTH, HGRN_HEAD_DIM), 0.02),
        'w_out': nrm(ks[12], (DEPTH, MIX_WIDTH, d), BETA * MIX_WIDTH ** -0.5),
        'ln_w': 1.0 + nrm(ks[13], (DEPTH, 2, d), 0.02),
        'ln_b': nrm(ks[14], (DEPTH, 2, d), 0.02),
        'w_router': nrm(ks[15], (DEPTH, d, N_EXPERTS), d ** -0.5),
        'w_gate': nrm(ks[16], (DEPTH, N_EXPERTS, d, EXPERT_FF), d ** -0.5),
        'w_up': nrm(ks[17], (DEPTH, N_EXPERTS, d, EXPERT_FF), d ** -0.5),
        'w_down': nrm(ks[18], (DEPTH, N_EXPERTS, EXPERT_FF, d), BETA * EXPERT_FF ** -0.5),
    }


def reference(x, c, ctx, c_ctx, w_mod, b_mod, w_in, w_conv, lambda_qk, subln_w, hgrn_lb_logits,
              hgrn_norm_w, w_out, ln_w, ln_b, w_router, w_gate, w_up, w_down):
    n = x.shape[1]
    rows = n // GRID_W
    row = jnp.repeat(jnp.arange(rows, dtype=jnp.float32), GRID_W)
    col = jnp.tile(jnp.arange(GRID_W, dtype=jnp.float32), rows)
    lb = jnp.cumsum(jax.nn.softmax(hgrn_lb_logits.astype(jnp.float32), axis=1), axis=1)
    lb = lb - lb[:, :1]

    for l in range(DEPTH):
        need_ctx = l < DEPTH - 1
        lambda_init = 0.8 - 0.6 * math.exp(-0.3 * l)
        mod = jax.nn.silu(c) @ w_mod[l] + b_mod[l]
        mod_c = jax.nn.silu(c_ctx) @ w_mod[l] + b_mod[l]
        sh1, sc1, g1, sh2, sc2, g2 = jnp.split(mod[:, None, :], 6, axis=-1)
        csh1, csc1, cg1, csh2, csc2, cg2 = jnp.split(mod_c, 6, axis=-1)

        y, y_c = hybrid_mixer(x * (1.0 + sc1) + sh1, ctx * (1.0 + csc1) + csh1, w_in[l], w_conv[l],
                              lambda_qk[l], lambda_init, subln_w[l], lb[0, l], lb[1, l], hgrn_norm_w[l],
                              w_out[l], row, col, need_ctx)
        x = layer_norm(ALPHA * x + g1 * y, ln_w[l, 0], ln_b[l, 0])
        moe = expert_choice_moe(x * (1.0 + sc2) + sh2, w_router[l], w_gate[l], w_up[l], w_down[l])
        x = layer_norm(ALPHA * x + g2 * moe, ln_w[l, 1], ln_b[l, 1])

        if need_ctx:
            ctx = layer_norm(ALPHA * ctx + cg1 * y_c, ln_w[l, 0], ln_b[l, 0])
            moe_c = expert_choice_moe(ctx * (1.0 + csc2) + csh2, w_router[l], w_gate[l], w_up[l], w_down[l])
            ctx = layer_norm(ALPHA * ctx + cg2 * moe_c, ln_w[l, 1], ln_b[l, 1])
    return x
```

```cpp
#define MK_REP 0u

#include <hip/hip_runtime.h>
#include <cstdio>
#include <cstdint>

constexpr int DM = 2048, NBATCH = 2, SEQ = 8192, CTXL = 256, DEPTH = 2;
constexpr int NLAT = NBATCH * SEQ;
constexpr int NCTX = NBATCH * CTXL;
constexpr int MROWS = NLAT + NCTX;
constexpr int PROJ_W = 7168, ATT_W = 1024, CONV_W = 512, HG_W = 512;
constexpr int NEXP = 16, EFF = 1024, CAP = 1024, CAPC = 32;
constexpr int NCHUNK = 132;
constexpr int NSCAN = 16;
constexpr float ALPHA_RES = 1.4142135623730951f;
constexpr float LN_EPS = 1e-6f;
constexpr int XG_LAT_ROWS = NEXP * 2048;
constexpr int XG_ROWS = XG_LAT_ROWS + NEXP * 256;

namespace pg8 {
#define PG8_LAS __attribute__((address_space(3)))
typedef unsigned short bf16_t;
typedef short bf16x8 __attribute__((ext_vector_type(8)));
typedef float f32x4 __attribute__((ext_vector_type(4)));
typedef unsigned u32x4 __attribute__((ext_vector_type(4)));
constexpr int BM = 256, BK = 64, HALF = 128, HTB = HALF * BK * 2  , STAGE_BYTES = 8 * HTB, NXCD = 8, WGM = 8;

__host__ __device__ __forceinline__ int lds_byte(int r, int c) { const int st = (r >> 4) * 2 + (c >> 5), rr = r & 15, cc = c & 31, ob = rr * 64 + cc * 2; return st * 1024 + (ob ^ (((ob >> 9) & 1) << 5)); }
__host__ __device__ __forceinline__ void stage_rc(int b, int& R, int& C) { const int st = b / 1024, sb = b % 1024, swz = sb ^ (((sb >> 9) & 1) << 5); R = (st >> 1) * 16 + swz / 64; C = (st & 1) * 32 + (swz % 64) / 2; }
__host__ __device__ __forceinline__ int perm32(int rho) { const int n = rho >> 4, i = rho & 15; return 8 * (i >> 2) + 4 * n + (i & 3); }

struct Unit { int pm, pn; };
struct Gemm { const bf16_t* A; const bf16_t* Bt; int M, N, K; };

struct StaticOrder {
    int nM, nN, nwg, G, c;
    __host__ __device__ void init(int M, int N, int G_, int c_) { nM = M / BM; nN = N / BM; nwg = nM * nN; G = G_; c = c_; }
    __host__ __device__ bool next(int i, Unit& u) const {
        const long L = (long)i * G + c; if (L >= nwg) return false;
        int wgid = (int)L; { const int q = nwg / NXCD, r = nwg % NXCD, xcd = wgid % NXCD, off = wgid / NXCD; wgid = (xcd < r ? xcd * (q + 1) : r * (q + 1) + (xcd - r) * q) + off; }
        const int nig = WGM * nN, gid = wgid / nig, fm = gid * WGM, gsz = (nM - fm) < WGM ? (nM - fm) : WGM;
        u.pm = fm + ((wgid % nig) % gsz); u.pn = (wgid % nig) / gsz; return true;
    }
    __device__ __forceinline__ void a_ready(const Unit&) const {}
    __device__ __forceinline__ void done(const Unit&) const {}
};

__device__ __forceinline__ unsigned cvt_pk_bf16(float lo, float hi) { unsigned r; asm volatile("v_cvt_pk_bf16_f32 %0, %1, %2" : "=v"(r) : "v"(lo), "v"(hi)); return r; }

typedef unsigned u32x2 __attribute__((ext_vector_type(2)));
struct EpiProj {
    static constexpr bool PERM = false, AFTER_DRAIN = false;
    bf16_t* QKV;
    bf16_t* CG;
    float*  GF;
    __device__ __forceinline__ void operator()(const f32x4 (&acc)[2][2][4][2], const Unit& u, int wr, int wc, int fr, int fq) const {
        const int pn = u.pn;
        const int row0 = u.pm * BM + wr * 64 + fr;
        if (pn >= 24) {
            float* base = GF + (size_t)((pn - 24) >> 1) * ((size_t)MROWS * 512) + ((pn - 24) & 1) * 256 + wc * 32 + 4 * fq;
#pragma unroll
            for (int ai = 0; ai < 2; ++ai)
#pragma unroll
                for (int m = 0; m < 4; ++m) { float* rowp = base + (size_t)(row0 + ai * HALF + m * 16) * 512;
#pragma unroll
                    for (int bj = 0; bj < 2; ++bj)
#pragma unroll
                        for (int n = 0; n < 2; ++n) *(f32x4*)(rowp + bj * HALF + n * 16) = acc[ai][bj][m][n]; }
            return;
        }
        bf16_t* base; int ld; bool rope = false;
        if (pn < 12) { base = QKV + (size_t)(pn >> 2) * ((size_t)MROWS * 1024) + (pn & 3) * 256; ld = 1024; rope = (pn < 8) && (u.pm < 64); }
        else { base = CG + (size_t)((pn - 12) >> 1) * ((size_t)MROWS * 512) + ((pn - 12) & 1) * 256; ld = 512; }
        base += wc * 32 + 4 * fq;
        if (rope) {
            f32x4 inv;
#pragma unroll
            for (int j = 0; j < 4; ++j) inv[j] = exp2f(-(float)(4 * fq + j) * (13.287712379549449f / 16.0f));
#pragma unroll
            for (int ai = 0; ai < 2; ++ai)
#pragma unroll
                for (int m = 0; m < 4; ++m) { const int row = row0 + ai * HALF + m * 16; const int t = row & (SEQ - 1);
                    const float pos = (float)((wc & 1) ? (t & 63) : (t >> 6));
                    f32x4 cs, sn;
#pragma unroll
                    for (int j = 0; j < 4; ++j) { const float ang = pos * inv[j]; cs[j] = __cosf(ang); sn[j] = __sinf(ang); }
                    bf16_t* rowp = base + (size_t)row * ld;
#pragma unroll
                    for (int bj = 0; bj < 2; ++bj) { const f32x4 x1 = acc[ai][bj][m][0], x2 = acc[ai][bj][m][1];
                        const f32x4 o1 = x1 * cs - x2 * sn, o2 = x2 * cs + x1 * sn;
                        u32x2 w1, w2; w1.x = cvt_pk_bf16(o1[0], o1[1]); w1.y = cvt_pk_bf16(o1[2], o1[3]); w2.x = cvt_pk_bf16(o2[0], o2[1]); w2.y = cvt_pk_bf16(o2[2], o2[3]);
                        *(u32x2*)(rowp + bj * HALF) = w1; *(u32x2*)(rowp + bj * HALF + 16) = w2; } }
        } else {
#pragma unroll
            for (int ai = 0; ai < 2; ++ai)
#pragma unroll
                for (int m = 0; m < 4; ++m) { bf16_t* rowp = base + (size_t)(row0 + ai * HALF + m * 16) * ld;
#pragma unroll
                    for (int bj = 0; bj < 2; ++bj)
#pragma unroll
                        for (int n = 0; n < 2; ++n) { const f32x4 v = acc[ai][bj][m][n]; u32x2 w; w.x = cvt_pk_bf16(v[0], v[1]); w.y = cvt_pk_bf16(v[2], v[3]);
                            *(u32x2*)(rowp + bj * HALF + n * 16) = w; } }
        }
    }
};
struct EpiOut {
    static constexpr bool PERM = false, AFTER_DRAIN = false;
    const float* xin_lat; const float* xin_ctx; float* Z; const float* modl;
    __device__ __forceinline__ void operator()(const f32x4 (&acc)[2][2][4][2], const Unit& u, int wr, int wc, int fr, int fq) const {
        const int brow = u.pm < 32 ? 0 : (u.pm < 64 ? 1 : 2);
        const int row0 = u.pm * BM + wr * 64 + fr, col0 = u.pn * BM + wc * 32 + 4 * fq;
        const float* g1 = modl + (size_t)brow * 12288 + 4096 + col0;
        const float* xin = (u.pm < 64) ? xin_lat : (xin_ctx - (size_t)NLAT * DM);
        f32x4 gv[2][2];
#pragma unroll
        for (int bj = 0; bj < 2; ++bj)
#pragma unroll
            for (int n = 0; n < 2; ++n) gv[bj][n] = *(const f32x4*)(g1 + bj * HALF + n * 16);
#pragma unroll
        for (int ai = 0; ai < 2; ++ai)
#pragma unroll
            for (int m = 0; m < 4; ++m) { const size_t off = (size_t)(row0 + ai * HALF + m * 16) * DM + col0;
#pragma unroll
                for (int bj = 0; bj < 2; ++bj)
#pragma unroll
                    for (int n = 0; n < 2; ++n) { const f32x4 xv = *(const f32x4*)(xin + off + bj * HALF + n * 16);
                        *(f32x4*)(Z + off + bj * HALF + n * 16) = xv * ALPHA_RES + gv[bj][n] * acc[ai][bj][m][n]; }
                asm volatile("" ::: "memory"); }
    }
};
__device__ __forceinline__ float silu_f(float a) { return a * __builtin_amdgcn_rcpf(1.0f + __expf(-a)); }
struct EpiMoe1 {
    static constexpr bool PERM = true, AFTER_DRAIN = false;
    bf16_t* H;
    __device__ __forceinline__ void operator()(const f32x4 (&acc)[2][2][4][2], const Unit& u, int wr, int wc, int fr, int fq) const {
        const int row0 = u.pm * BM + wr * 64 + fr, col0 = (u.pn & 7) * 128 + wc * 32 + 8 * fq;
#pragma unroll
        for (int ai = 0; ai < 2; ++ai)
#pragma unroll
            for (int m = 0; m < 4; ++m) { bf16_t* rowp = H + (size_t)(row0 + ai * HALF + m * 16) * EFF + col0;
                const f32x4 g0 = acc[ai][0][m][0], g1 = acc[ai][0][m][1], u0 = acc[ai][1][m][0], u1 = acc[ai][1][m][1];
                f32x4 h0, h1;
#pragma unroll
                for (int j = 0; j < 4; ++j) { h0[j] = silu_f(g0[j]) * u0[j]; h1[j] = silu_f(g1[j]) * u1[j]; }
                u32x4 w; w.x = cvt_pk_bf16(h0[0], h0[1]); w.y = cvt_pk_bf16(h0[2], h0[3]); w.z = cvt_pk_bf16(h1[0], h1[1]); w.w = cvt_pk_bf16(h1[2], h1[3]);
                *(u32x4*)rowp = w; }
    }
};
struct EpiMoe2 {
    static constexpr bool PERM = true, AFTER_DRAIN = false;
    bf16_t* Y;
    __device__ __forceinline__ void operator()(const f32x4 (&acc)[2][2][4][2], const Unit& u, int wr, int wc, int fr, int fq) const {
        const int row0 = u.pm * BM + wr * 64 + fr, col0 = (u.pn & 7) * BM + wc * 32 + 8 * fq;
#pragma unroll
        for (int ai = 0; ai < 2; ++ai)
#pragma unroll
            for (int m = 0; m < 4; ++m) { bf16_t* rowp = Y + (size_t)(row0 + ai * HALF + m * 16) * DM + col0;
#pragma unroll
                for (int bj = 0; bj < 2; ++bj) { const f32x4 v0 = acc[ai][bj][m][0], v1 = acc[ai][bj][m][1];
                    u32x4 w; w.x = cvt_pk_bf16(v0[0], v0[1]); w.y = cvt_pk_bf16(v0[2], v0[3]); w.z = cvt_pk_bf16(v1[0], v1[1]); w.w = cvt_pk_bf16(v1[2], v1[3]);
                    *(u32x4*)(rowp + bj * HALF) = w; } }
    }
};
struct MoeOrder {
    int G, c, ntot;
    __device__ bool next(int i, Unit& u) const {
        const long L = (long)i * G + c; if (L >= ntot) return false;
        if (L < 1024) { const int e = (int)L >> 6, r = (int)L & 63; u.pm = e * 8 + (r & 7); u.pn = e * 8 + (r >> 3); }
        else { const int Lc = (int)L - 1024, e = Lc >> 3; u.pm = 128 + e; u.pn = e * 8 + (Lc & 7); }
        return true;
    }
    __device__ __forceinline__ void a_ready(const Unit&) const {}
    __device__ __forceinline__ void done(const Unit&) const {}
};

template <class Epi, class Sched, bool ALIGN_EPI = false, bool SP2 = false, bool GATHER = false>
__device__ __forceinline__ void gemm_phase(PG8_LAS unsigned char* lds, const Gemm g, const Sched& S, const Epi& E, const int* rowsrc = nullptr) {
    static_assert(!GATHER || SP2, "gathered A rows are wired into the SP2 loop only");
    int tid_l = threadIdx.x; asm volatile("" : "+v"(tid_l));
    const int tid = tid_l, wid = __builtin_amdgcn_readfirstlane(tid >> 6), lane = tid & 63, wr = wid >> 2, wc = wid & 3, fr = lane & 15, fq = lane >> 4;
    const int K = g.K, nt = K / BK;
    unsigned voffA[2], voffB[2];
#pragma unroll
    for (int i = 0; i < 2; ++i) { int R, C; stage_rc(tid * 16 + i * 8192, R, C); const int Rb = Epi::PERM ? ((R & ~31) + perm32(R & 31)) : R;
        voffA[i] = (unsigned)(R * K + C) * 2u; voffB[i] = (unsigned)(Rb * K + C) * 2u; }
    const size_t kstep = (size_t)(BK * 2);
    const size_t hstep = (size_t)HALF * K * 2;
    const size_t tstep = 2 * hstep;
    const unsigned ldsw = (unsigned)wid * 1024u;
    const int aoff = lds_byte(wr * 64 + fr, fq * 8), boff = lds_byte(wc * 32 + fr, fq * 8);
#define PG8_SA(b, h) (((b) * 2 + (h)) * HTB)
#define PG8_SB(b, h) ((4 + (b) * 2 + (h)) * HTB)
#define PG8_STAGE(bufoff, gbase, voff) do { _Pragma("unroll") for (int _i = 0; _i < 2; ++_i) \
        __builtin_amdgcn_global_load_lds((const unsigned*)((const char*)(gbase) + (voff)[_i]), (PG8_LAS unsigned*)(lds + (bufoff) + ldsw + _i * 8192), 16, 0, 0); } while (0)
#define PG8_GOFF(u_, go_) do { _Pragma("unroll") for (int _h = 0; _h < 2; ++_h) _Pragma("unroll") for (int _i = 0; _i < 2; ++_i) { int R_, C_; stage_rc(tid * 16 + _i * 8192, R_, C_); \
        go_[_h][_i] = (unsigned)rowsrc[(u_).pm * BM + _h * HALF + R_] * (unsigned)(K * 2) + (unsigned)(C_ * 2); } } while (0)
#define PG8_STAGE_A(bufoff, gbase, h_, nx_) do { if constexpr (GATHER) { _Pragma("unroll") for (int _i = 0; _i < 2; ++_i) { const unsigned o_ = (nx_) ? goffN[h_][_i] : goffC[h_][_i]; \
        __builtin_amdgcn_global_load_lds((const unsigned*)((const char*)(gbase) + o_), (PG8_LAS unsigned*)(lds + (bufoff) + ldsw + _i * 8192), 16, 0, 0); } } \
    else { PG8_STAGE(bufoff, (gbase) + (h_) * hstep, voffA); } } while (0)
#define PG8_LDA(dst, b, h) do { _Pragma("unroll") for (int m = 0; m < 4; ++m) _Pragma("unroll") for (int k = 0; k < 2; ++k) dst[m][k] = *(const PG8_LAS bf16x8*)(lds + PG8_SA(b, h) + aoff + m * 2048 + k * 1024); } while (0)
#define PG8_LDB(dst, b, h) do { _Pragma("unroll") for (int n = 0; n < 2; ++n) _Pragma("unroll") for (int k = 0; k < 2; ++k) dst[n][k] = *(const PG8_LAS bf16x8*)(lds + PG8_SB(b, h) + boff + n * 2048 + k * 1024); } while (0)
#define PG8_MMA(ai, bj, At, Bt) do { __builtin_amdgcn_s_setprio(1); _Pragma("unroll") for (int m = 0; m < 4; ++m) _Pragma("unroll") for (int n = 0; n < 2; ++n) _Pragma("unroll") for (int k = 0; k < 2; ++k) \
        acc[ai][bj][m][n] = __builtin_amdgcn_mfma_f32_16x16x32_bf16(Bt[n][k], At[m][k], acc[ai][bj][m][n], 0, 0, 0); __builtin_amdgcn_s_setprio(0); } while (0)
#define PG8_WAIT_V(n) asm volatile("s_waitcnt vmcnt(" #n ")" ::: "memory")
#define PG8_WAIT_L(n) asm volatile("s_waitcnt lgkmcnt(" #n ")" ::: "memory")
#define PG8_BAR __builtin_amdgcn_s_barrier()
#define PG8_SCHED __builtin_amdgcn_sched_barrier(0)
    Unit cur, nxt; int ui = 0;
    if (!S.next(0, cur)) return;
    f32x4 acc[2][2][4][2];
#pragma unroll
    for (int a = 0; a < 2; ++a)
#pragma unroll
        for (int b = 0; b < 2; ++b)
#pragma unroll
            for (int m = 0; m < 4; ++m)
#pragma unroll
                for (int n = 0; n < 2; ++n) acc[a][b][m][n] = (f32x4){0.f, 0.f, 0.f, 0.f};
    bf16x8 At[4][2], B0[2][2], B1[2][2];
    const char* cA = GATHER ? (const char*)g.A : (const char*)g.A + (size_t)cur.pm * tstep; const char* cB = (const char*)g.Bt + (size_t)cur.pn * tstep;
    unsigned goffC[2][2] = {{0u, 0u}, {0u, 0u}}, goffN[2][2] = {{0u, 0u}, {0u, 0u}};
    if constexpr (GATHER) { PG8_GOFF(cur, goffC); }
    S.a_ready(cur);
    if constexpr (SP2) {
        PG8_STAGE(PG8_SB(0, 0), cB, voffB); PG8_STAGE(PG8_SB(0, 1), cB + hstep, voffB); PG8_STAGE_A(PG8_SA(0, 0), cA, 0, false); PG8_STAGE_A(PG8_SA(0, 1), cA, 1, false);
        if (wr == 1) PG8_BAR;
        PG8_WAIT_V(2); PG8_BAR;
        PG8_STAGE(PG8_SB(1, 0), cB + kstep, voffB); PG8_STAGE_A(PG8_SA(1, 0), cA + kstep, 0, false); PG8_STAGE(PG8_SB(1, 1), cB + hstep + kstep, voffB);
        PG8_WAIT_V(6); PG8_BAR;
    } else {
        PG8_STAGE(PG8_SB(0, 0), cB, voffB); PG8_STAGE(PG8_SA(0, 0), cA, voffA); PG8_STAGE(PG8_SB(0, 1), cB + hstep, voffB); PG8_STAGE(PG8_SA(0, 1), cA + hstep, voffA);
        if (wr == 1) PG8_BAR;
        PG8_WAIT_V(4); PG8_BAR;
        PG8_STAGE(PG8_SB(1, 0), cB + kstep, voffB); PG8_STAGE(PG8_SA(1, 0), cA + kstep, voffA); PG8_STAGE(PG8_SB(1, 1), cB + hstep + kstep, voffB);
        PG8_WAIT_V(6); PG8_BAR;
    }
    for (;;) {
        const bool has_next = S.next(ui + 1, nxt);
        const char* nA = GATHER ? cA : (has_next ? (const char*)g.A + (size_t)nxt.pm * tstep : cA);
        if constexpr (GATHER) { if (has_next) { PG8_GOFF(nxt, goffN); } else { _Pragma("unroll") for (int _h = 0; _h < 2; ++_h) _Pragma("unroll") for (int _i = 0; _i < 2; ++_i) goffN[_h][_i] = goffC[_h][_i]; } } const char* nB = has_next ? (const char*)g.Bt + (size_t)nxt.pn * tstep : cB;
        for (int t = 0; t < nt; t += 2) {
            const bool last = (t == nt - 2);
            const char* a1 = cA + (size_t)(t + 1) * kstep;
            const char* a2 = last ? nA : cA + (size_t)(t + 2) * kstep; const char* b2 = last ? nB : cB + (size_t)(t + 2) * kstep;
            const char* a3 = a2 + kstep; const char* b3 = b2 + kstep;
            if (last && has_next) S.a_ready(nxt);
            if constexpr (SP2) {
            PG8_LDB(B0, 0, 0); PG8_LDB(B1, 0, 1); PG8_SCHED; PG8_LDA(At, 0, 0); PG8_STAGE_A(PG8_SA(1, 1), a1, 1, false);
            PG8_WAIT_V(8); PG8_WAIT_L(0); PG8_BAR; PG8_MMA(0, 0, At, B0); PG8_MMA(0, 1, At, B1); PG8_BAR; PG8_SCHED;
            PG8_LDA(At, 0, 1); PG8_STAGE(PG8_SB(0, 0), b2, voffB); PG8_STAGE(PG8_SB(0, 1), b2 + hstep, voffB); PG8_STAGE_A(PG8_SA(0, 0), a2, 0, last);
            PG8_WAIT_V(8); PG8_WAIT_L(0); PG8_BAR; PG8_MMA(1, 0, At, B0); PG8_MMA(1, 1, At, B1); PG8_BAR; PG8_SCHED;
            PG8_LDB(B0, 1, 0); PG8_LDB(B1, 1, 1); PG8_SCHED; PG8_LDA(At, 1, 0); PG8_STAGE_A(PG8_SA(0, 1), a2, 1, last);
            PG8_WAIT_V(8); PG8_WAIT_L(0); PG8_BAR; PG8_MMA(0, 0, At, B0); PG8_MMA(0, 1, At, B1); PG8_BAR; PG8_SCHED;
            PG8_LDA(At, 1, 1); PG8_STAGE(PG8_SB(1, 0), b3, voffB); PG8_STAGE(PG8_SB(1, 1), b3 + hstep, voffB); PG8_STAGE_A(PG8_SA(1, 0), a3, 0, last);
            PG8_WAIT_V(8); PG8_WAIT_L(0); PG8_BAR; PG8_MMA(1, 0, At, B0); PG8_MMA(1, 1, At, B1); PG8_BAR; PG8_SCHED;
            } else {
            PG8_LDB(B0, 0, 0); PG8_SCHED; PG8_LDA(At, 0, 0); PG8_STAGE(PG8_SA(1, 1), a1 + hstep, voffA);
            PG8_WAIT_L(8); PG8_BAR; PG8_WAIT_L(0); PG8_MMA(0, 0, At, B0); PG8_BAR; PG8_SCHED;
            PG8_LDB(B1, 0, 1); PG8_STAGE(PG8_SB(0, 0), b2, voffB);
            PG8_BAR; PG8_WAIT_L(0); PG8_MMA(0, 1, At, B1); PG8_BAR;
            PG8_LDA(At, 0, 1); PG8_STAGE(PG8_SA(0, 0), a2, voffA);
            PG8_BAR; PG8_WAIT_L(0); PG8_MMA(1, 0, At, B0); PG8_BAR; PG8_SCHED;
            PG8_STAGE(PG8_SB(0, 1), b2 + hstep, voffB);
            PG8_WAIT_V(6); PG8_BAR; PG8_MMA(1, 1, At, B1); PG8_BAR;
            PG8_LDB(B0, 1, 0); PG8_SCHED; PG8_LDA(At, 1, 0); PG8_STAGE(PG8_SA(0, 1), a2 + hstep, voffA);
            PG8_WAIT_L(8); PG8_BAR; PG8_WAIT_L(0); PG8_MMA(0, 0, At, B0); PG8_BAR; PG8_SCHED;
            PG8_LDB(B1, 1, 1); PG8_STAGE(PG8_SB(1, 0), b3, voffB);
            PG8_BAR; PG8_WAIT_L(0); PG8_MMA(0, 1, At, B1); PG8_BAR;
            PG8_LDA(At, 1, 1); PG8_STAGE(PG8_SA(1, 0), a3, voffA);
            PG8_BAR; PG8_WAIT_L(0); PG8_MMA(1, 0, At, B0); PG8_BAR; PG8_SCHED;
            PG8_STAGE(PG8_SB(1, 1), b3 + hstep, voffB);
            PG8_WAIT_V(6); PG8_BAR; PG8_MMA(1, 1, At, B1); PG8_BAR;
            }
        }
        if constexpr (ALIGN_EPI) { if (wr == 0) PG8_BAR; }
        if constexpr (!Epi::AFTER_DRAIN) { E(acc, cur, wr, wc, fr, fq); S.done(cur); }
        if (!has_next) break;
#pragma unroll
        for (int a = 0; a < 2; ++a)
#pragma unroll
            for (int b = 0; b < 2; ++b)
#pragma unroll
                for (int m = 0; m < 4; ++m)
#pragma unroll
                    for (int n = 0; n < 2; ++n) acc[a][b][m][n] = (f32x4){0.f, 0.f, 0.f, 0.f};
        cur = nxt; cA = nA; cB = nB; ++ui;
        if constexpr (GATHER) { _Pragma("unroll") for (int _h = 0; _h < 2; ++_h) _Pragma("unroll") for (int _i = 0; _i < 2; ++_i) goffC[_h][_i] = goffN[_h][_i]; }
        if constexpr (ALIGN_EPI) { if (wr == 1) PG8_BAR; }
    }
    PG8_WAIT_V(0);
    if constexpr (!ALIGN_EPI) { if (wr == 0) PG8_BAR; }
    PG8_BAR;
    if constexpr (Epi::AFTER_DRAIN) { E.fused(acc, cur, wr, wc, fr, fq, lds, wid, lane); S.done(cur); }
#undef PG8_SA
#undef PG8_SB
#undef PG8_STAGE
#undef PG8_GOFF
#undef PG8_STAGE_A
#undef PG8_LDA
#undef PG8_LDB
#undef PG8_MMA
#undef PG8_WAIT_V
#undef PG8_WAIT_L
#undef PG8_BAR
#undef PG8_SCHED
}
}

constexpr size_t MiB = 1u << 20;
constexpr size_t WS_CTL = 0, CTL_ZERO_BYTES = 1 * MiB;
constexpr size_t WS_MOD = 1 * MiB;
constexpr size_t WS_AFF = 2 * MiB;
constexpr size_t WS_AFFC = WS_AFF + (size_t)NBATCH * NEXP * SEQ * 4;
constexpr size_t WS_IDX = 4 * MiB;
constexpr size_t WS_IDXC = WS_IDX + 32 * 1024 * 4, WS_GATE = WS_IDXC + 32 * 32 * 4, WS_GATEC = WS_GATE + 32 * 1024 * 4;
constexpr size_t WS_ROWSRC = WS_IDX + 512 * 1024;
constexpr size_t WS_INV = 5 * MiB;
constexpr size_t WS_HD = 7 * MiB;
constexpr size_t WS_WIN = 10 * MiB;
constexpr size_t WS_WOUT = 66 * MiB;
constexpr size_t WS_WGU = 82 * MiB;
constexpr size_t WS_WD = 338 * MiB;
constexpr size_t WS_R1 = 466 * MiB;
constexpr size_t WS_R2C = 598 * MiB;
constexpr size_t WS_XM = 602 * MiB;
constexpr size_t WS_STAGE = 668 * MiB;
constexpr size_t WS_QKV = WS_STAGE;
constexpr size_t WS_CG = WS_QKV + 3 * (size_t)MROWS * 1024 * 2;
constexpr size_t WS_GF = WS_CG + 6 * (size_t)MROWS * 512 * 2;
constexpr size_t WS_MIX = WS_GF + 2 * (size_t)MROWS * 512 * 4;
constexpr size_t WS_HU = WS_MIX + (size_t)MROWS * 2048 * 2;
constexpr size_t WS_HS = WS_HU + (size_t)NSCAN * NCHUNK * 16384 * 4;
constexpr size_t WS_STAGE_END = WS_HS + (size_t)NSCAN * NCHUNK * 16384 * 2;
constexpr size_t WS_Z = WS_HU;
constexpr size_t WS_XG = WS_STAGE;
constexpr size_t WS_HID = WS_XG + (size_t)XG_ROWS * 2048 * 2;
constexpr size_t WS_Y = WS_HID + (size_t)XG_ROWS * 1024 * 2;
constexpr size_t WS_MOE_END = WS_Y + (size_t)XG_ROWS * 2048 * 2;
constexpr size_t WS_END = WS_STAGE_END > WS_MOE_END ? WS_STAGE_END : WS_MOE_END;
static_assert(WS_WIN + (size_t)DEPTH * PROJ_W * DM * 2 <= WS_WOUT && WS_WOUT + (size_t)DEPTH * DM * DM * 2 <= WS_WGU && WS_WGU + (size_t)DEPTH * NEXP * 2048 * 2048 * 2 <= WS_WD &&
              WS_WD + (size_t)DEPTH * NEXP * 2048 * 1024 * 2 <= WS_R1 && WS_R1 + (size_t)MROWS * DM * 4 <= WS_R2C && WS_R2C + (size_t)NCTX * DM * 4 <= WS_XM && WS_XM + (size_t)MROWS * DM * 2 <= WS_STAGE, "d_ws map");
static_assert(WS_AFFC + (size_t)NBATCH * NEXP * CTXL * 4 <= WS_IDX && WS_GATEC + 32 * 32 * 4 <= WS_INV && WS_INV + (size_t)MROWS * 16 * 4 <= WS_HD && WS_HD + (size_t)NSCAN * NCHUNK * 128 * 4 <= WS_WIN, "d_ws small map");
static_assert(WS_END <= (size_t)1236 * MiB, "d_ws must fit in sum(inputs) = 1236.4 MiB");
constexpr int CW_BAR = 4096;

constexpr int RING_BYTES = 131072;
constexpr int MISC_OFF = RING_BYTES + 320;
constexpr int LDS_BYTES = 147456;
constexpr int NWAVES = 8;

#define GAS __attribute__((address_space(1)))
#define LAS __attribute__((address_space(3)))
typedef unsigned short bf16;
typedef unsigned v4u __attribute__((ext_vector_type(4)));
typedef unsigned v2u __attribute__((ext_vector_type(2)));
typedef float f32x4 __attribute__((ext_vector_type(4)));
typedef float f32x2 __attribute__((ext_vector_type(2)));
typedef short bf16x8 __attribute__((ext_vector_type(8)));
#define LDS_WAIT() asm volatile("s_waitcnt lgkmcnt(0)" ::: "memory")
#define VM_WAIT() asm volatile("s_waitcnt vmcnt(0)" ::: "memory")
__device__ __forceinline__ unsigned f2bf(float f) { unsigned u = __builtin_bit_cast(unsigned, f); return (u + 0x7fffu + ((u >> 16) & 1u)) >> 16; }
__device__ __forceinline__ unsigned pk2(float lo, float hi) { return f2bf(lo) | (f2bf(hi) << 16); }
__device__ __forceinline__ float bf2f(unsigned short b) { return __builtin_bit_cast(float, ((unsigned)b) << 16); }
__device__ __forceinline__ float bflo(unsigned w) { return __builtin_bit_cast(float, w << 16); }
__device__ __forceinline__ float bfhi(unsigned w) { return __builtin_bit_cast(float, w & 0xffff0000u); }
__device__ __forceinline__ float wave_sum(float v) {
#pragma unroll
    for (int o = 1; o < 64; o <<= 1) v += __shfl_xor(v, o);
    return v;
}
__device__ __forceinline__ float sigmoid_f(float z) { return 1.0f / (1.0f + expf(-z)); }

#define XB_TMO      128
#define XB_XCNT(j)  (256  + 64 * (j))
#define XB_XSUB(j)  (1280 + 64 * (j))
#define XB_XGEN(j)  (2304 + 64 * (j))
#define XB_TOP      3328
#define XB_TOPGEN   3392
#define XCD_BAR_WORDS 3456
#define XB_SPIN_CAP (1u << 18)

__device__ __forceinline__ unsigned xb_ld(unsigned* p)              { return __hip_atomic_load(p, __ATOMIC_RELAXED, __HIP_MEMORY_SCOPE_AGENT); }
__device__ __forceinline__ unsigned xb_add(unsigned* p, unsigned v) { return __hip_atomic_fetch_add(p, v, __ATOMIC_RELAXED, __HIP_MEMORY_SCOPE_AGENT); }
__device__ __forceinline__ unsigned xb_xcc_id() { return (unsigned)__builtin_amdgcn_s_getreg((3 << 11) | 20) & 0xFu; }
#define XB_SPIN(cond, bar) do { unsigned _sp = 0; while (cond) { __builtin_amdgcn_s_sleep(1); \
    if ((++_sp & 255u) == 0u) { if (xb_ld(&(bar)[XB_TMO])) break; if (_sp > XB_SPIN_CAP) { atomicAdd(&(bar)[XB_TMO], 1u); break; } } } } while (0)

struct XcdBarrier {
    unsigned* bar; unsigned x;
    volatile LAS unsigned* st;
};

__device__ __forceinline__ XcdBarrier xcd_barrier_post(unsigned* bar, volatile LAS unsigned* st) {
    XcdBarrier b; b.bar = bar; b.x = xb_xcc_id(); b.st = st;
    if (threadIdx.x == 0) (void)xb_add(&bar[XB_XCNT(b.x)], 1u);
    return b;
}
__device__ __forceinline__ void xcd_barrier_complete(unsigned* bar, unsigned x, unsigned& nloc, unsigned& nx) {
    const unsigned G = gridDim.x * gridDim.y * gridDim.z;
    unsigned sum, cnt, mine, sp = 0u;
    for (;;) {
        sum = 0u; cnt = 0u; mine = 0u;
#pragma unroll
        for (unsigned j = 0; j < 16; ++j) { const unsigned c = xb_ld(&bar[XB_XCNT(j)]); sum += c; cnt += (c > 0u) ? 1u : 0u; mine = (j == x) ? c : mine; }
        if (sum == G) break;
        __builtin_amdgcn_s_sleep(1);
        if ((++sp & 255u) == 0u) { if (xb_ld(&bar[XB_TMO])) break; if (sp > XB_SPIN_CAP) { atomicAdd(&bar[XB_TMO], 1u); break; } }
    }
    nloc = mine > 0u ? mine : 1u; nx = cnt > 0u ? cnt : 1u;
}

__device__ __forceinline__ void xcd_barrier(const XcdBarrier& b) {
    asm volatile("s_waitcnt vmcnt(0)" ::: "memory");
    __syncthreads();
    if (threadIdx.x == 0) {
        unsigned* bar = b.bar;
        __builtin_amdgcn_s_waitcnt(0);
        unsigned nloc = b.st[0], nx = b.st[1];
        if (nloc == 0u) { xcd_barrier_complete(bar, b.x, nloc, nx); b.st[0] = nloc; b.st[1] = nx; }
        const unsigned old = xb_add(&bar[XB_XSUB(b.x)], 1u);
        const unsigned gen = old / nloc;
        if (old + 1u == (gen + 1u) * nloc) {
            __builtin_amdgcn_fence(__ATOMIC_RELEASE, "agent");
            asm volatile("s_waitcnt vmcnt(0)" ::: "memory");
            const unsigned og = xb_add(&bar[XB_TOP], 1u);
            const unsigned tg = og / nx;
            if (og + 1u == (tg + 1u) * nx) xb_add(&bar[XB_TOPGEN], 1u);
            else XB_SPIN(xb_ld(&bar[XB_TOPGEN]) == tg, bar);
            __builtin_amdgcn_fence(__ATOMIC_ACQUIRE, "agent");
            xb_add(&bar[XB_XGEN(b.x)], 1u);
            asm volatile("s_waitcnt vmcnt(0)" ::: "memory");
        } else {
            XB_SPIN(xb_ld(&bar[XB_XGEN(b.x)]) == gen, bar);
            __builtin_amdgcn_fence(__ATOMIC_ACQUIRE, "agent");
            asm volatile("s_waitcnt vmcnt(0)" ::: "memory");
        }
    }
    __syncthreads();
}


namespace att {
typedef short s16x4 __attribute__((ext_vector_type(4)));
typedef float f32x16 __attribute__((ext_vector_type(16)));
typedef unsigned u32x4 __attribute__((ext_vector_type(4)));
constexpr int KVBLK = 64, LDK = 1024;
constexpr float SCALE = 0.125f;
constexpr float THR = 8.f;
constexpr int SHM_V = KVBLK * 128 * 2, SHM_K = KVBLK * 128 * 2, SHM_ATTN = 2 * SHM_V + 2 * SHM_K + NWAVES * 64 * 4;
#define KSWZ(row, colB) ((row) * 256 + ((colB) ^ (((row) & 7) << 4)))
#define SBAR() __builtin_amdgcn_sched_barrier(0)
__device__ __forceinline__ int crow(int r, int hi) { return (r & 3) + 8 * (r >> 2) + 4 * hi; }
__device__ __forceinline__ unsigned cvtpk(float lo, float hi) { unsigned r; asm volatile("v_cvt_pk_bf16_f32 %0, %1, %2" : "=v"(r) : "v"(lo), "v"(hi)); return r; }
__device__ __forceinline__ void partialSM(f32x16& p0, f32x16& p1, float& m_reg, float& mn, float& alpha) {
  constexpr float C = SCALE * 1.4426950408889634f;
  float pmax = p0[0]; for (int r = 1; r < 16; ++r) pmax = fmaxf(pmax, p0[r]); for (int r = 0; r < 16; ++r) pmax = fmaxf(pmax, p1[r]);
  { auto rr = __builtin_amdgcn_permlane32_swap(__float_as_uint(pmax), __float_as_uint(pmax), false, false);
    pmax = fmaxf(__uint_as_float(rr[0]), __uint_as_float(rr[1])); }
  if (__builtin_expect(__all(pmax - m_reg <= THR / SCALE), 1)) { mn = m_reg; alpha = 1.f; }
  else { mn = fmaxf(m_reg, pmax); alpha = __builtin_amdgcn_exp2f((m_reg - mn) * C); m_reg = mn; }
  float mnC = -mn * C;
  for (int r = 0; r < 16; ++r) p0[r] = fmaf(p0[r], C, mnC); for (int r = 0; r < 16; ++r) p1[r] = fmaf(p1[r], C, mnC);
  for (int r = 0; r < 16; ++r) p0[r] = __builtin_amdgcn_exp2f(p0[r]);
}
__device__ __forceinline__ void finishSM(f32x16& p0, f32x16& p1, float alpha, float& l_reg, bf16x8& pa0, bf16x8& pa1, bf16x8& pa2, bf16x8& pa3) {
  for (int r = 0; r < 16; ++r) p1[r] = __builtin_amdgcn_exp2f(p1[r]);
  float ps = 0; for (int r = 0; r < 16; ++r) ps += p0[r]; for (int r = 0; r < 16; ++r) ps += p1[r];
  { auto rr = __builtin_amdgcn_permlane32_swap(__float_as_uint(ps), __float_as_uint(ps), false, false);
    ps = __uint_as_float(rr[0]) + __uint_as_float(rr[1]); }
  l_reg = l_reg * alpha + ps;
#define PK4(P, BASE, OUT) do { unsigned a0 = cvtpk(P[BASE + 0], P[BASE + 1]), a1 = cvtpk(P[BASE + 2], P[BASE + 3]);   \
    unsigned b0 = cvtpk(P[BASE + 4], P[BASE + 5]), b1 = cvtpk(P[BASE + 6], P[BASE + 7]);                              \
    auto r0 = __builtin_amdgcn_permlane32_swap(a0, b0, false, false); auto r1 = __builtin_amdgcn_permlane32_swap(a1, b1, false, false); \
    u32x4 w = {r0[0], r1[0], r0[1], r1[1]}; OUT = *reinterpret_cast<bf16x8*>(&w); } while (0)
  PK4(p0, 0, pa0); PK4(p0, 8, pa1); PK4(p1, 0, pa2); PK4(p1, 8, pa3);
#undef PK4
}
__device__ __forceinline__ void qkt(f32x16& p0, f32x16& p1, const char* Ks, const bf16x8* qr, int r32, int hi, int sb) {
  p0 = f32x16{}; p1 = f32x16{};
#pragma unroll
  for (int d0 = 0; d0 < 4; ++d0) { int cb = sb + (d0 * 16 + hi * 8) * 2;
    bf16x8 b0 = *reinterpret_cast<const bf16x8*>(Ks + KSWZ(r32, cb));
    bf16x8 b1 = *reinterpret_cast<const bf16x8*>(Ks + KSWZ(32 + r32, cb));
    p0 = __builtin_amdgcn_mfma_f32_32x32x16_bf16(b0, qr[d0], p0, 0, 0, 0);
    p1 = __builtin_amdgcn_mfma_f32_32x32x16_bf16(b1, qr[d0], p1, 0, 0, 0); }
}
__device__ __forceinline__ int v_st(int k, int c) { const int kk = (k & ~0xC) | ((k & 4) << 1) | ((k & 8) >> 1); return ((kk >> 3) * 4 + (c >> 5)) * 512 + ((kk & 7) * 32 + (c & 31)) * 2; }
__device__ __forceinline__ int v_rd_base(int lane) { return ((lane & 3) << 3) | (((lane >> 2) & 3) << 6) | (((lane >> 4) & 1) << 5) | (((lane >> 5) & 1) << 8); }
constexpr int v_rd_off(int d0, int ks, int half) { return d0 * 512 + ks * 4096 + half * 2048; }
template <int OFF> __device__ __forceinline__ s16x4 tr_read(int vb) {
  s16x4 r; asm volatile("ds_read_b64_tr_b16 %0, %1 offset:%2" : "=&v"(r) : "v"(vb), "i"(OFF) : "memory"); return r;
}
struct VFrag { s16x4 l0, h0, l1, h1, l2, h2, l3, h3; };
template <int D0> __device__ __forceinline__ void v_frag_read(VFrag& f, int vb) {
  f.l0 = tr_read<v_rd_off(D0, 0, 0)>(vb); f.h0 = tr_read<v_rd_off(D0, 0, 1)>(vb); f.l1 = tr_read<v_rd_off(D0, 1, 0)>(vb); f.h1 = tr_read<v_rd_off(D0, 1, 1)>(vb);
  f.l2 = tr_read<v_rd_off(D0, 2, 0)>(vb); f.h2 = tr_read<v_rd_off(D0, 2, 1)>(vb); f.l3 = tr_read<v_rd_off(D0, 3, 0)>(vb); f.h3 = tr_read<v_rd_off(D0, 3, 1)>(vb);
}
__device__ __forceinline__ void pv_mma(f32x16& od, const VFrag& f, bf16x8 pa0, bf16x8 pa1, bf16x8 pa2, bf16x8 pa3) {
#define PK(L, H) (bf16x8){L[0], L[1], L[2], L[3], H[0], H[1], H[2], H[3]}
  od = __builtin_amdgcn_mfma_f32_32x32x16_bf16(pa0, PK(f.l0, f.h0), od, 0, 0, 0);
  od = __builtin_amdgcn_mfma_f32_32x32x16_bf16(pa1, PK(f.l1, f.h1), od, 0, 0, 0);
  od = __builtin_amdgcn_mfma_f32_32x32x16_bf16(pa2, PK(f.l2, f.h2), od, 0, 0, 0);
  od = __builtin_amdgcn_mfma_f32_32x32x16_bf16(pa3, PK(f.l3, f.h3), od, 0, 0, 0);
#undef PK
}
__device__ __forceinline__ void pv_d0(f32x16* o, int vb, bf16x8 pa0, bf16x8 pa1, bf16x8 pa2, bf16x8 pa3) {
  VFrag fa, fb;
  v_frag_read<0>(fa, vb);
  asm volatile("s_waitcnt lgkmcnt(0)" ::: "memory"); SBAR();
  v_frag_read<1>(fb, vb); SBAR();
  pv_mma(o[0], fa, pa0, pa1, pa2, pa3); SBAR();
  asm volatile("s_waitcnt lgkmcnt(0)" ::: "memory"); SBAR();
  v_frag_read<2>(fa, vb); SBAR();
  pv_mma(o[1], fb, pa0, pa1, pa2, pa3); SBAR();
  asm volatile("s_waitcnt lgkmcnt(0)" ::: "memory"); SBAR();
  v_frag_read<3>(fb, vb); SBAR();
  pv_mma(o[2], fa, pa0, pa1, pa2, pa3); SBAR();
  asm volatile("s_waitcnt lgkmcnt(0)" ::: "memory"); SBAR();
  pv_mma(o[3], fb, pa0, pa1, pa2, pa3);
}

constexpr int NKS = 3, NVS = 4, LDS_KR = 0, LDS_VR = NKS * SHM_K, LDS_WS = LDS_VR + NVS * SHM_V;
__device__ __forceinline__ void attn_unit(const bf16* __restrict__ Qb, const bf16* __restrict__ Kh, const bf16* __restrict__ Vh, int klat0, int nlt, int kctx0, int NT,
                                          float lam, float post, const float* __restrict__ subw, bf16* __restrict__ Ob, char* lds) {
  int tid_l = threadIdx.x; asm volatile("" : "+v"(tid_l));
  const int tid = tid_l, wid = __builtin_amdgcn_readfirstlane(tid >> 6), lane = tid & 63, r32 = lane & 31, hi = lane >> 5;
  const int sbr = wid >> 2, wq = wid & 3, sb = sbr * 128;
  char* K_lds = lds + LDS_KR; char* V_lds = lds + LDS_VR;
  float* ws = (float*)(lds + LDS_WS) + wid * 64; float* li_l = ws; float* al_l = ws + 32;
  float m_reg = -1e30f, l_reg = 0; f32x16 o[4] = {}; bf16x8 qr[4];
  const bf16* Qw = Qb + (long)(wq * 32 + r32) * LDK + sbr * 64 + hi * 8;
#pragma unroll
  for (int d0 = 0; d0 < 4; ++d0) qr[d0] = *reinterpret_cast<const bf16x8*>(Qw + d0 * 16);
  unsigned koff[2], voff[2];
#pragma unroll
  for (int q = 0; q < 2; ++q) { const int ch = (q * 8 + wid) * 64 + lane;
    { const int row = ch >> 4, cpos = ch & 15, csrc = cpos ^ (row & 7); koff[q] = (unsigned)(row * LDK + csrc * 8) * 2u; }
    { const int pb = ch * 16, sub = pb >> 9, within = (pb & 511) >> 1, kk = (sub >> 2) * 8 + (within >> 5), c = (sub & 3) * 32 + (within & 31);
      const int k = (kk & ~0xC) | ((kk & 4) << 1) | ((kk & 8) >> 1); voff[q] = (unsigned)(k * LDK + c) * 2u; } }
  const int vb0 = (int)(uintptr_t)V_lds + v_rd_base(lane);
  const unsigned ldsw = (unsigned)wid * 1024u;
  typedef __attribute__((address_space(3))) unsigned lds_u32;
#define KROW(jt) ((jt) < nlt ? (long)klat0 + (long)(jt) * KVBLK : (long)kctx0 + (long)((jt) - nlt) * KVBLK)
#define DMA_TILE(jt) do { const long kb_ = KROW(jt) * (LDK * 2); const char* kg_ = (const char*)Kh + kb_; const char* vg_ = (const char*)Vh + kb_; \
    const unsigned ks_ = (unsigned)(((jt) % NKS) * SHM_K) + ldsw, vs_ = (unsigned)(LDS_VR + ((jt) % NVS) * SHM_V) + ldsw; \
    _Pragma("unroll") for (int q_ = 0; q_ < 2; ++q_) { \
      __builtin_amdgcn_global_load_lds((const unsigned*)(kg_ + koff[q_]), (lds_u32*)(uintptr_t)((unsigned)(uintptr_t)lds + ks_ + q_ * 8192u), 16, 0, 0); \
      __builtin_amdgcn_global_load_lds((const unsigned*)(vg_ + voff[q_]), (lds_u32*)(uintptr_t)((unsigned)(uintptr_t)lds + vs_ + q_ * 8192u), 16, 0, 0); } } while (0)
#define TILE_BAR(n) do { asm volatile("s_waitcnt vmcnt(" #n ")" ::: "memory"); __builtin_amdgcn_s_barrier(); asm volatile("" ::: "memory"); } while (0)
#define RESC(a) do { if (__any((a) < 1.f)) { if (hi == 0) al_l[r32] = (a); asm volatile("s_waitcnt lgkmcnt(0)" ::: "memory"); \
    for (int d = 0; d < 4; ++d) for (int r = 0; r < 16; ++r) o[d][r] *= al_l[crow(r, hi)]; } } while (0)
#define KS(jt) (K_lds + ((jt) % NKS) * SHM_K)
#define VB(jt) (vb0 + ((jt) % NVS) * SHM_V)
  f32x16 pA0, pA1, pB0, pB1; float mnA, mnB, alA, alB; bf16x8 pa0, pa1, pa2, pa3;
  DMA_TILE(0); DMA_TILE(1); TILE_BAR(4);
  DMA_TILE(2);
  qkt(pA0, pA1, KS(0), qr, r32, hi, sb); partialSM(pA0, pA1, m_reg, mnA, alA);
  TILE_BAR(4);
  if (sbr == 0) {
    for (int j = 1; j + 1 < NT; j += 2) {
      if (j + 2 < NT) DMA_TILE(j + 2);
      SBAR(); qkt(pB0, pB1, KS(j), qr, r32, hi, sb);
      finishSM(pA0, pA1, alA, l_reg, pa0, pa1, pa2, pa3); SBAR();
      pv_d0(o, VB(j - 1), pa0, pa1, pa2, pa3); partialSM(pB0, pB1, m_reg, mnB, alB);
      RESC(alB);
      if (j + 2 < NT) TILE_BAR(4); else TILE_BAR(0);
      if (j + 3 < NT) DMA_TILE(j + 3);
      SBAR(); qkt(pA0, pA1, KS(j + 1), qr, r32, hi, sb);
      finishSM(pB0, pB1, alB, l_reg, pa0, pa1, pa2, pa3); SBAR();
      pv_d0(o, VB(j), pa0, pa1, pa2, pa3); partialSM(pA0, pA1, m_reg, mnA, alA);
      RESC(alA);
      if (j + 3 < NT) TILE_BAR(4); else TILE_BAR(0);
    }
  } else {
    for (int j = 1; j + 1 < NT; j += 2) {
      if (j + 2 < NT) DMA_TILE(j + 2);
      SBAR(); finishSM(pA0, pA1, alA, l_reg, pa0, pa1, pa2, pa3); SBAR();
      qkt(pB0, pB1, KS(j), qr, r32, hi, sb); SBAR();
      partialSM(pB0, pB1, m_reg, mnB, alB); SBAR();
      pv_d0(o, VB(j - 1), pa0, pa1, pa2, pa3);
      RESC(alB);
      if (j + 2 < NT) TILE_BAR(4); else TILE_BAR(0);
      if (j + 3 < NT) DMA_TILE(j + 3);
      SBAR(); finishSM(pB0, pB1, alB, l_reg, pa0, pa1, pa2, pa3); SBAR();
      qkt(pA0, pA1, KS(j + 1), qr, r32, hi, sb); SBAR();
      partialSM(pA0, pA1, m_reg, mnA, alA); SBAR();
      pv_d0(o, VB(j), pa0, pa1, pa2, pa3);
      RESC(alA);
      if (j + 3 < NT) TILE_BAR(4); else TILE_BAR(0);
    }
  }
  SBAR(); qkt(pB0, pB1, KS(NT - 1), qr, r32, hi, sb);
  finishSM(pA0, pA1, alA, l_reg, pa0, pa1, pa2, pa3); SBAR();
  pv_d0(o, VB(NT - 2), pa0, pa1, pa2, pa3); partialSM(pB0, pB1, m_reg, mnB, alB);
  RESC(alB);
  finishSM(pB0, pB1, alB, l_reg, pa0, pa1, pa2, pa3); SBAR();
  pv_d0(o, VB(NT - 1), pa0, pa1, pa2, pa3);
  if (hi == 0) li_l[r32] = l_reg; asm volatile("s_waitcnt lgkmcnt(0)" ::: "memory");
  int hi_e = hi, r32_e = r32, wq_e = wq;
  asm volatile("" : "+v"(hi_e), "+v"(r32_e), "+v"(wq_e));
  float rli[16];
#pragma unroll
  for (int r = 0; r < 16; ++r) rli[r] = 1.0f / li_l[crow(r, hi_e)];
#pragma unroll
  for (int d0 = 0; d0 < 4; ++d0)
#pragma unroll
    for (int r = 0; r < 16; ++r) o[d0][r] *= rli[r];
  asm volatile("s_waitcnt vmcnt(0)" ::: "memory");
  __syncthreads();
  float* X = (float*)lds;
  if (sbr == 1) {
#pragma unroll
    for (int d0 = 0; d0 < 4; ++d0)
#pragma unroll
      for (int r = 0; r < 16; ++r) X[(wq_e * 32 + crow(r, hi_e)) * 128 + d0 * 32 + r32_e] = o[d0][r];
  }
  __syncthreads();
  if (sbr == 0) {
    float sw[4];
#pragma unroll
    for (int d0 = 0; d0 < 4; ++d0) sw[d0] = subw[d0 * 32 + r32_e] * post;
    bf16* Ow = Ob + (long)(wq_e * 32) * DM;
#pragma unroll
    for (int r = 0; r < 16; ++r) { const int orow = crow(r, hi_e); float v[4]; float ss = 0.f;
#pragma unroll
      for (int d0 = 0; d0 < 4; ++d0) { v[d0] = o[d0][r] - lam * X[(wq_e * 32 + orow) * 128 + d0 * 32 + r32_e]; ss += v[d0] * v[d0]; }
      ss += __shfl_xor(ss, 1); ss += __shfl_xor(ss, 2); ss += __shfl_xor(ss, 4); ss += __shfl_xor(ss, 8); ss += __shfl_xor(ss, 16);
      const float rs = 1.0f / sqrtf(ss * (1.0f / 128.0f) + LN_EPS);
#pragma unroll
      for (int d0 = 0; d0 < 4; ++d0) Ow[(long)orow * DM + d0 * 32 + r32_e] = (bf16)f2bf(v[d0] * rs * sw[d0]); }
  }
  __syncthreads();
#undef KROW
#undef DMA_TILE
#undef TILE_BAR
#undef KS
#undef VB
#undef RESC
}
#undef KSWZ
}


struct Frame {
    LAS unsigned char* lds; char* ldsg;
    int tid, lane, wave, vcu, G;
    unsigned char* ws;
    const float *x, *c, *ctx, *c_ctx, *w_mod, *b_mod, *w_in, *w_conv, *lambda_qk, *subln_w, *lb_logits, *hgrn_norm_w, *w_out, *ln_w, *ln_b, *w_router, *w_gate, *w_up, *w_down;
    float* out;
};
__device__ __forceinline__ float lambda_init_of(int l) { return l == 0 ? 0.2f : 0.35550906759096926f; }

__device__ __forceinline__ void p0_transpose_item(const float* W, int K, int N, bf16* WT, int row_off, int mode, LAS float* scr, int item, int lane) {
    const int nblk = N / 32, kb = item / nblk, nb = item % nblk, k0 = 64 * kb, n0 = 32 * nb;
    float wv[32];
    const float* wp = W + (size_t)(k0 + (lane >> 5)) * N + n0 + (lane & 31);
#pragma unroll
    for (int i = 0; i < 32; ++i) wv[i] = wp[(size_t)(2 * i) * N];
#pragma unroll
    for (int i = 0; i < 32; ++i) { const int kk = 2 * i + (lane >> 5); scr[kk * 33 + (lane & 31)] = wv[i]; }
    LDS_WAIT(); asm volatile("" ::: "memory");
    const int cch = lane & 7;
#pragma unroll
    for (int j = 0; j < 4; ++j) { const int n = (lane >> 3) + 8 * j; const LAS float* s = scr + (8 * cch) * 33 + n;
        v4u o; o.x = pk2(s[0 * 33], s[1 * 33]); o.y = pk2(s[2 * 33], s[3 * 33]); o.z = pk2(s[4 * 33], s[5 * 33]); o.w = pk2(s[6 * 33], s[7 * 33]);
        const int nn = n0 + n; const int drow = mode ? (row_off + (nn >> 7) * 256 + (nn & 127)) : (row_off + nn);
        *(GAS v4u*)(WT + (size_t)drow * K + k0 + 8 * cch) = o; }
    LDS_WAIT(); asm volatile("" ::: "memory");
}
constexpr int CV_I_IN = (DM / 64) * (PROJ_W / 32), CV_I_OUT = (DM / 64) * (DM / 32), CV_I_GU = (DM / 64) * (EFF / 32), CV_I_DN = (EFF / 64) * (DM / 32);
constexpr int CV_N_IN = DEPTH * CV_I_IN, CV_N_OUT = DEPTH * CV_I_OUT, CV_N_G = DEPTH * NEXP * CV_I_GU, CV_N_D = DEPTH * NEXP * CV_I_DN;
constexpr int CV_NITEMS = CV_N_IN + CV_N_OUT + 2 * CV_N_G + CV_N_D;
constexpr int CV_DEFER0 = CV_I_IN + CV_I_OUT;
constexpr int CV_DEFER = 3 * NEXP * 1024;
constexpr int CV_S1 = 16000, CV_S2 = 33280, CV_S3 = 33280, CV_S4 = 33280;
static_assert(CV_I_GU == 1024 && CV_I_DN == 1024 && DEPTH == 2, "deferred-item numbering");
__device__ __forceinline__ void convert_item(Frame& F, int it) {
    LAS float* scr = (LAS float*)(F.lds + F.wave * 8704);
    bf16* WIN = (bf16*)(F.ws + WS_WIN); bf16* WOUT = (bf16*)(F.ws + WS_WOUT); bf16* WGU = (bf16*)(F.ws + WS_WGU); bf16* WD = (bf16*)(F.ws + WS_WD);
    int r = it;
    if (r < CV_N_IN) { const int l = r / CV_I_IN; p0_transpose_item(F.w_in + (size_t)l * DM * PROJ_W, DM, PROJ_W, WIN + (size_t)l * PROJ_W * DM, 0, 0, scr, r % CV_I_IN, F.lane); return; } r -= CV_N_IN;
    if (r < CV_N_OUT) { const int l = r / CV_I_OUT; p0_transpose_item(F.w_out + (size_t)l * DM * DM, DM, DM, WOUT + (size_t)l * DM * DM, 0, 0, scr, r % CV_I_OUT, F.lane); return; } r -= CV_N_OUT;
    if (r < CV_N_G) { const int le = r / CV_I_GU; p0_transpose_item(F.w_gate + (size_t)le * DM * EFF, DM, EFF, WGU + (size_t)le * 2048 * DM, 0, 1, scr, r % CV_I_GU, F.lane); return; } r -= CV_N_G;
    if (r < CV_N_G) { const int le = r / CV_I_GU; p0_transpose_item(F.w_up + (size_t)le * DM * EFF, DM, EFF, WGU + (size_t)le * 2048 * DM, 128, 1, scr, r % CV_I_GU, F.lane); return; } r -= CV_N_G;
    { const int le = r / CV_I_DN; p0_transpose_item(F.w_down + (size_t)le * EFF * DM, EFF, DM, WD + (size_t)le * DM * EFF, 0, 0, scr, r % CV_I_DN, F.lane); }
}
__device__ __forceinline__ bool cv_is_deferred(int it) {
    int r = it; if (r < CV_N_IN) return false; r -= CV_N_IN;
    if (r < CV_N_OUT) return false; r -= CV_N_OUT;
    if (r < CV_N_G) return r >= NEXP * 1024; r -= CV_N_G;
    if (r < CV_N_G) return r >= NEXP * 1024; r -= CV_N_G;
    return r >= NEXP * 1024;
}
__device__ __forceinline__ int cv_deferred_id(int b) {
    const int bb = b, t = bb / (NEXP * 1024), r = bb % (NEXP * 1024);
    return CV_N_IN + CV_N_OUT + t * CV_N_G + NEXP * 1024 + r;
}
__device__ __forceinline__ void deferred_convert(Frame& F, int lo, int hi, int rank, int nidle) {
    for (int b = lo + rank * NWAVES + F.wave; b < hi; b += nidle * NWAVES) convert_item(F, cv_deferred_id(b));
}
__device__ __forceinline__ void p0_prologue(Frame& F) {
    LAS float* sv = (LAS float*)(F.lds + 73728);
    LAS float* part = (LAS float*)(F.lds + 98304);
    for (int i = F.tid; i < 3 * DM; i += 512) { const float v = (i < 2 * DM) ? F.c[i] : F.c_ctx[i - 2 * DM]; sv[i] = v / (1.0f + expf(-v)); }
    __syncthreads();
    float* MOD = (float*)(F.ws + WS_MOD);
    for (int it = blockIdx.x; it < DEPTH * 384; it += F.G) {
        const int l = it / 384, n0 = (it % 384) * 32, kp = F.lane >> 5, col = F.lane & 31;
        const float* wb = F.w_mod + (size_t)l * DM * 12288; unsigned woff = (unsigned)(((F.wave * 2 + kp) * 12288 + n0 + col) * 4); asm volatile("" : "+v"(woff));
        float a0 = 0.f, a1 = 0.f, a2 = 0.f;
        for (int s0 = 0; s0 < 128; s0 += 32) {
            float wv[32];
#pragma unroll
            for (int u = 0; u < 32; ++u) wv[u] = *(const float*)((const char*)wb + (woff + (unsigned)((s0 + u) * 16 * 12288 * 4)));
#pragma unroll
            for (int u = 0; u < 32; ++u) { const int k = (s0 + u) * 16 + F.wave * 2 + kp;
                a0 = fmaf(sv[k], wv[u], a0); a1 = fmaf(sv[DM + k], wv[u], a1); a2 = fmaf(sv[2 * DM + k], wv[u], a2); } }
        LAS float* pp = part + ((F.wave * 2 + kp) * 32 + col) * 3; pp[0] = a0; pp[1] = a1; pp[2] = a2;
        __syncthreads();
        if (F.tid < 96) { const int cc = F.tid & 31, r = F.tid >> 5; float s = 0.f;
            for (int p = 0; p < 16; ++p) s += part[(p * 32 + cc) * 3 + r];
            MOD[((size_t)l * 3 + r) * 12288 + n0 + cc] = s + F.b_mod[(size_t)l * 12288 + n0 + cc]; }
        __syncthreads();
    }
    const int gw = F.vcu * NWAVES + F.wave, NGW = F.G * NWAVES;
    for (int it = gw; it < CV_NITEMS; it += NGW) {
        if (cv_is_deferred(it)) continue;
        convert_item(F, it);
    }
}
__device__ __forceinline__ void store_mod_bf16(bf16* orow, const f32x4 (&v)[8], const float* sh, const float* sc, int lane) {
#pragma unroll
    for (int j = 0; j < 8; ++j) { const int c = 256 * j + 4 * lane; const f32x4 s1 = *(const f32x4*)(sc + c), s0 = *(const f32x4*)(sh + c);
        const f32x4 h = v[j] * (s1 + 1.0f) + s0; v2u w; w.x = pk2(h[0], h[1]); w.y = pk2(h[2], h[3]); *(v2u*)(orow + c) = w; }
}
__device__ __forceinline__ void p1_modulate(Frame& F) {
    const int gw = F.vcu * NWAVES + F.wave, NGW = F.G * NWAVES;
    const float* MOD = (const float*)(F.ws + WS_MOD); bf16* XM = (bf16*)(F.ws + WS_XM);
    for (int row = gw; row < MROWS; row += NGW) {
        const int brow = row < NLAT ? (row >> 13) : 2;
        const float* xr = row < NLAT ? F.x + (size_t)row * DM : F.ctx + (size_t)(row - NLAT) * DM;
        f32x4 v[8];
#pragma unroll
        for (int j = 0; j < 8; ++j) v[j] = *(const f32x4*)(xr + 256 * j + 4 * F.lane);
        store_mod_bf16(XM + (size_t)row * DM, v, MOD + (size_t)brow * 12288, MOD + (size_t)brow * 12288 + DM, F.lane);
    }
}
__device__ __forceinline__ void ln_inplace(f32x4 (&v)[8], const float* w, const float* b, int lane) {
    float s = 0.f;
#pragma unroll
    for (int j = 0; j < 8; ++j) s += (v[j][0] + v[j][1]) + (v[j][2] + v[j][3]);
    const float mean = wave_sum(s) * (1.0f / DM); float q = 0.f;
#pragma unroll
    for (int j = 0; j < 8; ++j) { v[j] = v[j] - mean; q += (v[j][0] * v[j][0] + v[j][1] * v[j][1]) + (v[j][2] * v[j][2] + v[j][3] * v[j][3]); }
    const float rstd = 1.0f / sqrtf(wave_sum(q) * (1.0f / DM) + LN_EPS);
#pragma unroll
    for (int j = 0; j < 8; ++j) { const int c = 256 * j + 4 * lane; v[j] = v[j] * rstd * *(const f32x4*)(w + c) + *(const f32x4*)(b + c); }
}
__device__ __forceinline__ void conv_rows(Frame& F, int l, int nrows) {
    const int gw = F.vcu * NWAVES + F.wave, NGW = F.G * NWAVES;
    const bf16* CX = (const bf16*)(F.ws + WS_CG); const bf16* CB = CX + (size_t)MROWS * 512; const bf16* CC = CB + (size_t)MROWS * 512;
    bf16* MIX = (bf16*)(F.ws + WS_MIX);
    const float* wc = F.w_conv + (size_t)l * 3 * CONV_W + 8 * F.lane;
    float w0[8], w1[8], w2[8];
#pragma unroll
    for (int j = 0; j < 8; ++j) { w0[j] = wc[j]; w1[j] = wc[CONV_W + j]; w2[j] = wc[2 * CONV_W + j]; }
    for (int row = gw; row < nrows; row += NGW) {
        const int t = row < NLAT ? (row & (SEQ - 1)) : ((row - NLAT) & (CTXL - 1)); const int tl = row < NLAT ? SEQ - 1 : CTXL - 1;
        const size_t o = (size_t)row * 512 + 8 * F.lane;
        const v4u z4 = {0u, 0u, 0u, 0u};
        const v4u x1 = *(const v4u*)(CX + o), c1 = *(const v4u*)(CC + o), b1 = *(const v4u*)(CB + o);
        const v4u x0 = t > 0 ? *(const v4u*)(CX + o - 512) : z4, c0 = t > 0 ? *(const v4u*)(CC + o - 512) : z4;
        const v4u x2 = t < tl ? *(const v4u*)(CX + o + 512) : z4, c2 = t < tl ? *(const v4u*)(CC + o + 512) : z4;
        v4u ov;
#pragma unroll
        for (int q = 0; q < 4; ++q) {
            const float r0 = (bflo(c0[q]) * bflo(x0[q])) * w0[2 * q] + (bflo(c1[q]) * bflo(x1[q])) * w1[2 * q] + (bflo(c2[q]) * bflo(x2[q])) * w2[2 * q];
            const float r1 = (bfhi(c0[q]) * bfhi(x0[q])) * w0[2 * q + 1] + (bfhi(c1[q]) * bfhi(x1[q])) * w1[2 * q + 1] + (bfhi(c2[q]) * bfhi(x2[q])) * w2[2 * q + 1];
            ov[q] = pk2(bflo(b1[q]) * r0, bfhi(b1[q]) * r1); }
        *(v4u*)(MIX + (size_t)row * DM + ATT_W + 8 * F.lane) = ov;
    }
}
__device__ __forceinline__ void hg_rows(int b, int dir, int c, int& base, int& sgn) {
    if (dir == 0) { sgn = 1; base = (c < 4) ? (NLAT + b * CTXL + c * 64) : (b * SEQ + (c - 4) * 64); }
    else { sgn = -1; base = (c < 4) ? (NLAT + b * CTXL + CTXL - 1 - c * 64) : (b * SEQ + SEQ - 1 - (c - 4) * 64); }
}
__device__ __forceinline__ float hg_lb(const Frame& F, int l, int dir, int ch) {
    if (l == 0) return 0.f;
    const float x0 = F.lb_logits[(dir * DEPTH + 0) * HG_W + ch], x1 = F.lb_logits[(dir * DEPTH + 1) * HG_W + ch];
    return 1.0f / (1.0f + expf(x0 - x1));
}
typedef float f32x4v __attribute__((ext_vector_type(4)));
template <bool WITH_Q> __device__ __forceinline__ void hg_load(const float* zbuf, const bf16* GQ, const bf16* GI, int base, int sgn, int h, int d, int seg,
                                                              float (&z)[16], unsigned (&qv)[16]) {
    unsigned go = (unsigned)((base + sgn * (seg * 16)) * 512 + h * 128 + d) * 2u;
    asm volatile("" : "+v"(go));
    const unsigned st = (unsigned)(sgn * 1024);
#pragma unroll
    for (int j = 0; j < 16; ++j) { z[j] = *(const float*)((const char*)zbuf + 2u * go); unsigned w = *(const bf16*)((const char*)GI + go);
        if (WITH_Q) w |= ((unsigned)*(const bf16*)((const char*)GQ + go)) << 16; qv[j] = w; go += st; }
}
__device__ __forceinline__ void hg_stage1(const float (&zz)[16], int d, int seg, float lb, LAS float* segs, float (&a)[16], float (&kin)[16], float& atot) {
    float run = 0.f;
#pragma unroll
    for (int j = 0; j < 16; ++j) { const float z = fminf(fmaxf(zz[j], -80.f), 80.f);
        const float sg = __builtin_amdgcn_rcpf(1.0f + __expf(-z)); const float f = lb + (1.0f - lb) * sg;
        run += __log2f(f); a[j] = run; kin[j] = (1.0f - lb) * (1.0f - sg); }
    segs[seg * 128 + d] = run;
    __syncthreads();
    float off = 0.f, tot = 0.f;
#pragma unroll
    for (int s = 0; s < 4; ++s) { const float v = segs[s * 128 + d]; if (s < seg) off += v; tot += v; }
#pragma unroll
    for (int j = 0; j < 16; ++j) a[j] += off;
    atot = tot;
}
__device__ __forceinline__ void hg_h1_units(Frame& F, int l) {
    const int d = F.tid & 127, seg = F.tid >> 7, fr = F.lane & 15, fq = F.lane >> 4;
    LAS float* segs = (LAS float*)(F.lds + 0);
    LAS bf16* kdT = (LAS bf16*)(F.lds + 2048);
    LAS bf16* vT = (LAS bf16*)(F.lds + 2048 + 128 * 72 * 2);
    const bf16* GI = (const bf16*)(F.ws + WS_CG) + (size_t)4 * MROWS * 512;
    float z[16]; unsigned vv[16];
    int unit = blockIdx.x;
    if (unit < NSCAN * NCHUNK) { const int sc = unit / NCHUNK, c = unit % NCHUNK; int base, sgn; hg_rows((sc >> 2) & 1, sc >> 3, c, base, sgn);
        hg_load<false>((const float*)(F.ws + WS_GF) + (size_t)(sc >> 3) * MROWS * 512, GI, GI, base, sgn, sc & 3, d, seg, z, vv); }
    for (; unit < NSCAN * NCHUNK; unit += F.G) {
        const int sc = unit / NCHUNK, dir = sc >> 3, h = sc & 3;
        const float lb = hg_lb(F, l, dir, h * 128 + d);
        float a[16], kin[16], atot;
        hg_stage1(z, d, seg, lb, segs, a, kin, atot);
        { v4u kp[2], vp[2];
#pragma unroll
          for (int j = 0; j < 16; j += 2) { const unsigned kw = pk2(kin[j] * __builtin_amdgcn_exp2f(atot - a[j]), kin[j + 1] * __builtin_amdgcn_exp2f(atot - a[j + 1]));
              const unsigned vw = (vv[j] & 0xffffu) | (vv[j + 1] << 16); kp[j >> 3][(j >> 1) & 3] = kw; vp[j >> 3][(j >> 1) & 3] = vw; }
          *(LAS v4u*)(kdT + d * 72 + seg * 16) = kp[0]; *(LAS v4u*)(kdT + d * 72 + seg * 16 + 8) = kp[1];
          *(LAS v4u*)(vT + d * 72 + seg * 16) = vp[0]; *(LAS v4u*)(vT + d * 72 + seg * 16 + 8) = vp[1]; }
        if (seg == 0) ((float*)(F.ws + WS_HD))[(size_t)unit * 128 + d] = __builtin_amdgcn_exp2f(atot);
        { const int un = unit + F.G;
          if (un < NSCAN * NCHUNK) { const int scn = un / NCHUNK, cn = un % NCHUNK; int basen, sgnn; hg_rows((scn >> 2) & 1, scn >> 3, cn, basen, sgnn);
              hg_load<false>((const float*)(F.ws + WS_GF) + (size_t)(scn >> 3) * MROWS * 512, GI, GI, basen, sgnn, scn & 3, d, seg, z, vv); } }
        __syncthreads();
        bf16x8 kf[2];
#pragma unroll
        for (int ks = 0; ks < 2; ++ks) kf[ks] = *(const LAS bf16x8*)(kdT + (F.wave * 16 + fr) * 72 + ks * 32 + fq * 8);
        float* UT = (float*)(F.ws + WS_HU) + (size_t)unit * 16384;
#pragma unroll
        for (int nt = 0; nt < 8; ++nt) { f32x4v acc = {0.f, 0.f, 0.f, 0.f};
#pragma unroll
            for (int ks = 0; ks < 2; ++ks) { const bf16x8 vf = *(const LAS bf16x8*)(vT + (nt * 16 + fr) * 72 + ks * 32 + fq * 8);
                acc = __builtin_amdgcn_mfma_f32_16x16x32_bf16(kf[ks], vf, acc, 0, 0, 0); }
            *(f32x4v*)(UT + (size_t)(nt * 16 + fr) * 128 + F.wave * 16 + fq * 4) = acc; }
        __syncthreads();
    }
}
__device__ __forceinline__ void hg_h2(Frame& F) {
    const float* UT = (const float*)(F.ws + WS_HU); const float* HD = (const float*)(F.ws + WS_HD); bf16* HS = (bf16*)(F.ws + WS_HS);
    if (F.tid < 256) for (int e = (int)blockIdx.x * 256 + F.tid; e < NSCAN * 4096; e += F.G * 256) {
        const int sc = e >> 12, idx = (e & 4095) * 4, dk = idx & 127;
        const float* up = UT + (size_t)sc * NCHUNK * 16384 + idx; const float* dp = HD + (size_t)sc * NCHUNK * 128 + dk; bf16* sp = HS + (size_t)sc * NCHUNK * 16384 + idx;
        f32x4 S = {0.f, 0.f, 0.f, 0.f};
        for (int c0 = 0; c0 < NCHUNK; c0 += 12) {
            f32x4 u[12], dd[12];
#pragma unroll
            for (int k = 0; k < 12; ++k) { u[k] = *(const f32x4*)(up + (size_t)(c0 + k) * 16384); dd[k] = *(const f32x4*)(dp + (c0 + k) * 128); }
#pragma unroll
            for (int k = 0; k < 12; ++k) { v2u w; w.x = pk2(S[0], S[1]); w.y = pk2(S[2], S[3]); *(v2u*)(sp + (size_t)(c0 + k) * 16384) = w; S = dd[k] * S + u[k]; }
        }
    }
}
__device__ __forceinline__ void hg_h3_unit(Frame& F, int l, int unit) {
    const int bh = unit / NCHUNK, oc = unit % NCHUNK, b = bh >> 2, h = bh & 3;
    int t_l = F.tid; asm volatile("" : "+v"(t_l));
    const int d = t_l & 127, seg = t_l >> 7, fr = t_l & 15, fq = (t_l >> 4) & 3;
    LAS float* aS = (LAS float*)(F.lds + 0);
    LAS bf16* kS = (LAS bf16*)(F.lds + 32768);
    LAS bf16* qS = (LAS bf16*)(F.lds + 32768 + 17408);
    LAS bf16* vT = (LAS bf16*)(F.lds + 67584);
    LAS bf16* scS = (LAS bf16*)(F.lds + 86016);
    LAS float* OS = (LAS float*)(F.lds + 95232);
    LAS float* segs = (LAS float*)(F.lds + 128000);
    const bf16* GQ = (const bf16*)(F.ws + WS_CG) + (size_t)3 * MROWS * 512; const bf16* GI = GQ + (size_t)MROWS * 512; const bf16* GG = GI + (size_t)MROWS * 512;
    float zin[16]; unsigned qvin[16];
    { int base, sgn; hg_rows(b, 0, oc, base, sgn); hg_load<true>((const float*)(F.ws + WS_GF), GQ, GI, base, sgn, h, d, seg, zin, qvin); }
    int base0, sg0; hg_rows(b, 0, oc, base0, sg0);
    for (int dir = 0; dir < 2; ++dir) {
        const int c = dir == 0 ? oc : (oc < 4 ? 3 - oc : 135 - oc);
        const int sc = dir * 8 + b * 4 + h;
        const float lb = hg_lb(F, l, dir, h * 128 + d);
        { float a[16], kin[16], atot;
          hg_stage1(zin, d, seg, lb, segs, a, kin, atot);
#pragma unroll
          for (int j = 0; j < 16; ++j) { const int i = seg * 16 + j;
              aS[i * 128 + d] = a[j]; kS[i * 136 + d] = (bf16)f2bf(kin[j]); qS[i * 136 + d] = (bf16)(qvin[j] >> 16); }
          v4u vp[2];
#pragma unroll
          for (int j = 0; j < 16; j += 2) vp[j >> 3][(j >> 1) & 3] = (qvin[j] & 0xffffu) | (qvin[j + 1] << 16);
          *(LAS v4u*)(vT + d * 72 + seg * 16) = vp[0]; *(LAS v4u*)(vT + d * 72 + seg * 16 + 8) = vp[1]; }
        const bf16* Sst = (const bf16*)(F.ws + WS_HS) + ((size_t)sc * NCHUNK + c) * 16384;
        bf16x8 sfr[4][4];
#pragma unroll
        for (int q4 = 0; q4 < 4; ++q4)
#pragma unroll
            for (int ks = 0; ks < 4; ++ks) sfr[q4][ks] = *(const bf16x8*)((const char*)Sst + (unsigned)((((F.wave >> 2) * 64 + fr) * 128 + fq * 8) * 2) + (unsigned)(q4 * 4096 + ks * 64));
        if (dir == 0) { const int c1 = oc < 4 ? 3 - oc : 135 - oc; int base1, sgn1; hg_rows(b, 1, c1, base1, sgn1);
            hg_load<true>((const float*)(F.ws + WS_GF) + (size_t)MROWS * 512, GQ, GI, base1, sgn1, h, d, seg, zin, qvin); }
        for (int i = F.tid; i < 64 * 72 / 2; i += 512) ((LAS unsigned*)scS)[i] = 0u;
        __syncthreads();
        for (int blk = F.wave; blk < 10; blk += 8) {
            const int I = blk < 1 ? 0 : (blk < 3 ? 1 : (blk < 6 ? 2 : 3)); const int J = blk - (I * (I + 1)) / 2;
            f32x4v acc = {0.f, 0.f, 0.f, 0.f};
            const int ti = 16 * I + fr, tj = 16 * J + fr;
#pragma unroll
            for (int ks = 0; ks < 4; ++ks) { const int dk0 = 32 * ks + 8 * fq;
                f32x4 rho[2], ai[2], aj[2];
#pragma unroll
                for (int hh = 0; hh < 2; ++hh) { rho[hh] = I == 0 ? (f32x4){0.f, 0.f, 0.f, 0.f} : *(const LAS f32x4*)(aS + (16 * I - 1) * 128 + dk0 + 4 * hh);
                    ai[hh] = *(const LAS f32x4*)(aS + ti * 128 + dk0 + 4 * hh); aj[hh] = *(const LAS f32x4*)(aS + tj * 128 + dk0 + 4 * hh); }
                const bf16x8 qv = *(const LAS bf16x8*)(qS + ti * 136 + dk0), kv = *(const LAS bf16x8*)(kS + tj * 136 + dk0);
                bf16x8 af, bfr;
#pragma unroll
                for (int jj = 0; jj < 8; jj += 2) { const int hh = jj >> 2, e0 = jj & 3;
                    const float qa0 = bf2f((unsigned short)qv[jj]) * __builtin_amdgcn_exp2f(ai[hh][e0] - rho[hh][e0]), qa1 = bf2f((unsigned short)qv[jj + 1]) * __builtin_amdgcn_exp2f(ai[hh][e0 + 1] - rho[hh][e0 + 1]);
                    const float kb0 = bf2f((unsigned short)kv[jj]) * __builtin_amdgcn_exp2f(fminf(rho[hh][e0] - aj[hh][e0], 80.f)), kb1 = bf2f((unsigned short)kv[jj + 1]) * __builtin_amdgcn_exp2f(fminf(rho[hh][e0 + 1] - aj[hh][e0 + 1], 80.f));
                    const unsigned pa = pg8::cvt_pk_bf16(qa0, qa1), pb = pg8::cvt_pk_bf16(kb0, kb1);
                    af[jj] = (short)(pa & 0xffffu); af[jj + 1] = (short)(pa >> 16); bfr[jj] = (short)(pb & 0xffffu); bfr[jj + 1] = (short)(pb >> 16); }
                acc = __builtin_amdgcn_mfma_f32_16x16x32_bf16(af, bfr, acc, 0, 0, 0); }
#pragma unroll
            for (int r = 0; r < 4; ++r) { const int ii = 16 * I + 4 * fq + r, jj = 16 * J + fr; const float v = (jj <= ii) ? acc[r] : 0.f; scS[ii * 72 + jj] = (bf16)f2bf(v); }
        }
        __syncthreads();
        { const int mt = F.wave & 3, ti = 16 * mt + fr;
          bf16x8 sa[2], qa[4];
#pragma unroll
          for (int ks = 0; ks < 2; ++ks) sa[ks] = *(const LAS bf16x8*)(scS + ti * 72 + ks * 32 + fq * 8);
#pragma unroll
          for (int ks = 0; ks < 4; ++ks) { const int dk0 = 32 * ks + 8 * fq; const bf16x8 qv = *(const LAS bf16x8*)(qS + ti * 136 + dk0);
              const f32x4 a0 = *(const LAS f32x4*)(aS + ti * 128 + dk0), a1 = *(const LAS f32x4*)(aS + ti * 128 + dk0 + 4);
#pragma unroll
              for (int jj = 0; jj < 8; jj += 2) { const float e0 = __builtin_amdgcn_exp2f(jj < 4 ? a0[jj & 3] : a1[jj & 3]), e1 = __builtin_amdgcn_exp2f(jj < 4 ? a0[(jj & 3) + 1] : a1[(jj & 3) + 1]);
                  const unsigned pq = pg8::cvt_pk_bf16(bf2f((unsigned short)qv[jj]) * e0, bf2f((unsigned short)qv[jj + 1]) * e1);
                  qa[ks][jj] = (short)(pq & 0xffffu); qa[ks][jj + 1] = (short)(pq >> 16); } }
#pragma unroll
          for (int q4 = 0; q4 < 4; ++q4) { const int nt = (F.wave >> 2) * 4 + q4; f32x4v acc = {0.f, 0.f, 0.f, 0.f};
#pragma unroll
              for (int ks = 0; ks < 2; ++ks) { const bf16x8 vf = *(const LAS bf16x8*)(vT + (nt * 16 + fr) * 72 + ks * 32 + fq * 8);
                  acc = __builtin_amdgcn_mfma_f32_16x16x32_bf16(sa[ks], vf, acc, 0, 0, 0); }
#pragma unroll
              for (int ks = 0; ks < 4; ++ks) acc = __builtin_amdgcn_mfma_f32_16x16x32_bf16(qa[ks], sfr[q4][ks], acc, 0, 0, 0);
#pragma unroll
              for (int r = 0; r < 4; ++r) { const int is = 16 * mt + 4 * fq + r; const int ot = dir == 0 ? is : 63 - is; LAS float* op = OS + ot * 128 + nt * 16 + fr;
                  if (dir == 0) *op = acc[r]; else *op += acc[r]; } } }
        __syncthreads();
    }
    { const float nw0 = F.hgrn_norm_w[l * 128 + F.lane], nw1 = F.hgrn_norm_w[l * 128 + 64 + F.lane];
      bf16* MIX = (bf16*)(F.ws + WS_MIX);
      unsigned gin[8];
#pragma unroll
      for (int tt = 0; tt < 8; ++tt) { const unsigned go = (unsigned)(((base0 + F.wave * 8 + tt) * 512 + h * 128 + F.lane) * 2);
          gin[tt] = (unsigned)*(const bf16*)((const char*)GG + go) | ((unsigned)*(const bf16*)((const char*)GG + go + 128) << 16); }
#pragma unroll
      for (int tt = 0; tt < 8; ++tt) { const int t = F.wave * 8 + tt; const float v0 = OS[t * 128 + F.lane], v1 = OS[t * 128 + 64 + F.lane];
          const float ss = wave_sum(v0 * v0 + v1 * v1); const float rs = 1.0f / sqrtf(ss * (1.0f / 128.0f) + LN_EPS);
          const size_t row = (size_t)(base0 + t); const float g0 = bflo(gin[tt]), g1 = bfhi(gin[tt]);
          bf16* mp = MIX + row * DM + ATT_W + CONV_W + h * 128;
          mp[F.lane] = (bf16)f2bf(v0 * rs * nw0 * (g0 * __builtin_amdgcn_rcpf(1.0f + __expf(-g0)))); mp[64 + F.lane] = (bf16)f2bf(v1 * rs * nw1 * (g1 * __builtin_amdgcn_rcpf(1.0f + __expf(-g1)))); } }
    __syncthreads();
}
__device__ __forceinline__ void router_finish(Frame& F, float mine, int row, bool doit) {
    float mx = mine;
    mx = fmaxf(mx, __shfl_xor(mx, 1)); mx = fmaxf(mx, __shfl_xor(mx, 2)); mx = fmaxf(mx, __shfl_xor(mx, 4)); mx = fmaxf(mx, __shfl_xor(mx, 8));
    const float ex = expf(mine - mx);
    float den = ex;
    den += __shfl_xor(den, 1); den += __shfl_xor(den, 2); den += __shfl_xor(den, 4); den += __shfl_xor(den, 8);
    const float affv = ex / den;
    float* AFF = (float*)(F.ws + WS_AFF); float* AFFC = (float*)(F.ws + WS_AFFC);
    if (F.lane < 16 && doit) { if (row < NLAT) AFF[((size_t)(row >> 13) * NEXP + F.lane) * SEQ + (row & (SEQ - 1))] = affv;
                       else { const int rc = row - NLAT; AFFC[((size_t)(rc >> 8) * NEXP + F.lane) * CTXL + (rc & (CTXL - 1))] = affv; } }
}
__device__ __forceinline__ void ln1_router(Frame& F, int l, int nrows) {
    LAS float* RW = (LAS float*)(F.lds + 0);
    const float* wr = F.w_router + (size_t)l * DM * NEXP;
    for (int i = F.tid; i < DM * NEXP; i += 512) { const int cc = i >> 4, e = i & 15; RW[e * DM + cc] = wr[i]; }
    __syncthreads();
    const int gw = F.vcu * NWAVES + F.wave, NGW = F.G * NWAVES;
    const float* MOD = (const float*)(F.ws + WS_MOD) + (size_t)l * 3 * 12288;
    float* R1 = (float*)(F.ws + WS_R1); bf16* XM = (bf16*)(F.ws + WS_XM);
    const float* lw = F.ln_w + (size_t)(l * 2 + 0) * DM; const float* lbp = F.ln_b + (size_t)(l * 2 + 0) * DM;
    for (int row0 = gw; row0 < nrows; row0 += 2 * NGW) {
        const bool has1 = row0 + NGW < nrows; const int rows[2] = {row0, has1 ? row0 + NGW : row0};
        f32x4 v[2][8];
#pragma unroll
        for (int q = 0; q < 2; ++q) { const float* zr = (const float*)(F.ws + WS_Z) + (size_t)rows[q] * DM;
#pragma unroll
            for (int j = 0; j < 8; ++j) v[q][j] = *(const f32x4*)(zr + 256 * j + 4 * F.lane); }
#pragma unroll
        for (int q = 0; q < 2; ++q) { const int row = rows[q]; const int brow = row < NLAT ? (row >> 13) : 2;
            ln_inplace(v[q], lw, lbp, F.lane);
            if (q == 0 || has1) { float* xr1 = R1 + (size_t)row * DM;
#pragma unroll
                for (int j = 0; j < 8; ++j) *(f32x4*)(xr1 + 256 * j + 4 * F.lane) = v[q][j]; }
            const float* sh2 = MOD + (size_t)brow * 12288 + 3 * DM; const float* sc2 = sh2 + DM;
#pragma unroll
            for (int j = 0; j < 8; ++j) { const int cc = 256 * j + 4 * F.lane; v[q][j] = v[q][j] * (*(const f32x4*)(sc2 + cc) + 1.0f) + *(const f32x4*)(sh2 + cc); }
            if (q == 0 || has1) { bf16* xo = XM + (size_t)row * DM;
#pragma unroll
                for (int j = 0; j < 8; ++j) { v2u w; w.x = pk2(v[q][j][0], v[q][j][1]); w.y = pk2(v[q][j][2], v[q][j][3]); *(v2u*)(xo + 256 * j + 4 * F.lane) = w; } } }
        float mine0 = 0.f, mine1 = 0.f;
#pragma unroll 1
        for (int g = 0; g < 4; ++g) {
            float a0[4], a1[4];
#pragma unroll
            for (int k = 0; k < 4; ++k) { float x0 = 0.f, x1 = 0.f; const LAS float* wp = RW + (4 * g + k) * DM + 4 * F.lane;
#pragma unroll
                for (int j = 0; j < 8; ++j) { const f32x4 w4 = *(const LAS f32x4*)(wp + 256 * j);
                    x0 += (v[0][j][0] * w4[0] + v[0][j][1] * w4[1]) + (v[0][j][2] * w4[2] + v[0][j][3] * w4[3]);
                    x1 += (v[1][j][0] * w4[0] + v[1][j][1] * w4[1]) + (v[1][j][2] * w4[2] + v[1][j][3] * w4[3]); }
                a0[k] = x0; a1[k] = x1; }
            const bool u0 = F.lane & 1, u1 = (F.lane >> 1) & 1;
            float b00 = (u0 ? a0[1] : a0[0]) + __shfl_xor(u0 ? a0[0] : a0[1], 1), b01 = (u0 ? a0[3] : a0[2]) + __shfl_xor(u0 ? a0[2] : a0[3], 1);
            float b10 = (u0 ? a1[1] : a1[0]) + __shfl_xor(u0 ? a1[0] : a1[1], 1), b11 = (u0 ? a1[3] : a1[2]) + __shfl_xor(u0 ? a1[2] : a1[3], 1);
            float c0 = (u1 ? b01 : b00) + __shfl_xor(u1 ? b00 : b01, 2), c1 = (u1 ? b11 : b10) + __shfl_xor(u1 ? b10 : b11, 2);
#pragma unroll
            for (int o = 4; o < 64; o <<= 1) { c0 += __shfl_xor(c0, o); c1 += __shfl_xor(c1, o); }
            const bool sel = ((F.lane >> 2) & 3) == g; mine0 = sel ? c0 : mine0; mine1 = sel ? c1 : mine1;
        }
        router_finish(F, mine0, rows[0], true); router_finish(F, mine1, rows[1], has1);
    }
    __syncthreads();
}
__device__ __forceinline__ void topk_unit(Frame& F, int unit) {
    const bool isc = unit >= 32; const int be = isc ? unit - 32 : unit, b = be >> 4, e = be & 15;
    const int N = isc ? CTXL : SEQ, cap = isc ? CAPC : CAP;
    const float* aff = isc ? (const float*)(F.ws + WS_AFFC) + (size_t)be * CTXL : (const float*)(F.ws + WS_AFF) + (size_t)be * SEQ;
    int* IDX = isc ? (int*)(F.ws + WS_IDXC) + be * CAPC : (int*)(F.ws + WS_IDX) + be * CAP;
    float* GATE = isc ? (float*)(F.ws + WS_GATEC) + be * CAPC : (float*)(F.ws + WS_GATE) + be * CAP;
    int* INV = (int*)(F.ws + WS_INV) + (size_t)(isc ? NLAT + b * CTXL : b * SEQ) * 16 + e;
    int* ROWSRC = (int*)(F.ws + WS_ROWSRC) + (isc ? XG_LAT_ROWS + e * 256 + b * 32 : e * 2048 + b * 1024); const int rsrc0 = isc ? NLAT + b * CTXL : b * SEQ;
    LAS unsigned* hist = (LAS unsigned*)(F.lds + 0);
    LAS unsigned* ctl = (LAS unsigned*)(F.lds + 1024);
    LAS unsigned* wtot = (LAS unsigned*)(F.lds + 2048);
    unsigned key[16];
#pragma unroll
    for (int j = 0; j < 16; ++j) { const int n = F.tid * 16 + j; key[j] = n < N ? __float_as_uint(aff[n < N ? n : 0]) : 0u; }
    if (F.tid == 0) { ctl[0] = 0u; ctl[1] = (unsigned)cap; }
    for (int pass = 0; pass < 4; ++pass) {
        const int shift = 24 - 8 * pass;
        if (F.tid < 256) hist[F.tid] = 0u;
        __syncthreads();
        const unsigned prefix = ctl[0]; const unsigned himask = pass == 0 ? 0u : (0xffffffffu << (shift + 8));
#pragma unroll
        for (int j = 0; j < 16; ++j) { const int n = F.tid * 16 + j; if (n < N && (key[j] & himask) == prefix) atomicAdd((unsigned*)&hist[(key[j] >> shift) & 255u], 1u); }
        __syncthreads();
        if (F.wave == 0) {
            const unsigned need = ctl[1];
            const unsigned h0 = hist[4 * F.lane], h1 = hist[4 * F.lane + 1], h2 = hist[4 * F.lane + 2], h3 = hist[4 * F.lane + 3];
            const unsigned mysum = h0 + h1 + h2 + h3;
            unsigned suf = mysum;
#pragma unroll
            for (int o = 1; o < 64; o <<= 1) { const unsigned t = __shfl_down(suf, o); if (F.lane + o < 64) suf += t; }
            const unsigned above = suf - mysum;
            if (above < need && need <= suf) { unsigned cum = above; int bin;
                if (cum + h3 >= need) bin = 3; else { cum += h3; if (cum + h2 >= need) bin = 2; else { cum += h2; if (cum + h1 >= need) bin = 1; else { cum += h1; bin = 0; } } }
                ctl[0] = prefix | ((unsigned)(4 * F.lane + bin) << shift); ctl[1] = need - cum; }
        }
        __syncthreads();
    }
    const unsigned T = ctl[0], need = ctl[1];
    unsigned cnt = 0u;
#pragma unroll
    for (int j = 0; j < 16; ++j) { const int n = F.tid * 16 + j; if (n < N) cnt += (key[j] > T ? 0x10000u : 0u) + (key[j] == T ? 1u : 0u); }
    unsigned inc = cnt;
#pragma unroll
    for (int o = 1; o < 64; o <<= 1) { const unsigned t = __shfl_up(inc, o); if (F.lane >= o) inc += t; }
    if (F.lane == 63) wtot[F.wave] = inc;
    __syncthreads();
    unsigned woff = 0u, total = 0u;
#pragma unroll
    for (int w = 0; w < 8; ++w) { const unsigned t = wtot[w]; if (w < F.wave) woff += t; total += t; }
    unsigned excl = woff + inc - cnt;
    const unsigned ngt = total >> 16;
    unsigned g_before = excl >> 16, e_before = excl & 0xffffu;
#pragma unroll
    for (int j = 0; j < 16; ++j) { const int n = F.tid * 16 + j; if (n < N) {
        int slot = -1;
        if (key[j] > T) { slot = (int)g_before; ++g_before; }
        else if (key[j] == T) { if (e_before < need) slot = (int)(ngt + e_before); ++e_before; }
        INV[(size_t)n * 16] = slot;
        if (slot >= 0) { IDX[slot] = n; GATE[slot] = __uint_as_float(key[j]); ROWSRC[slot] = rsrc0 + n; } } }
    if (isc && b == 0 && F.tid < 192) ((int*)(F.ws + WS_ROWSRC))[XG_LAT_ROWS + e * 256 + 64 + F.tid] = NLAT;
    __syncthreads();
}
__device__ __forceinline__ void gather_rows(Frame& F, int l) {
    const int gw = F.vcu * NWAVES + F.wave, NGW = F.G * NWAVES;
    const bf16* XM = (const bf16*)(F.ws + WS_XM); bf16* XG = (bf16*)(F.ws + WS_XG);
    const int* IDX = (const int*)(F.ws + WS_IDX); const int* IDXC = (const int*)(F.ws + WS_IDXC);
    const int ntot = XG_LAT_ROWS + (l == 0 ? NEXP * 64 : 0);
    for (int r = gw; r < ntot; r += NGW) {
        size_t src, dst;
        if (r < XG_LAT_ROWS) { const int e = r >> 11, b = (r >> 10) & 1, slot = r & 1023; src = (size_t)(b * SEQ + IDX[(b * NEXP + e) * CAP + slot]); dst = (size_t)r; }
        else { const int rc = r - XG_LAT_ROWS, e = rc >> 6, b = (rc >> 5) & 1, slot = rc & 31; src = (size_t)(NLAT + b * CTXL + IDXC[(b * NEXP + e) * CAPC + slot]); dst = (size_t)(XG_LAT_ROWS + e * 256 + b * 32 + slot); }
        const v4u* sp = (const v4u*)(XM + src * DM) + F.lane; v4u* dp = (v4u*)(XG + dst * DM) + F.lane;
        v4u t0 = sp[0], t1 = sp[64], t2 = sp[128], t3 = sp[192];
        dp[0] = t0; dp[64] = t1; dp[128] = t2; dp[192] = t3;
    }
}
__device__ __forceinline__ void combine_ln2(Frame& F, int l, int nrows) {
    const int gw = F.vcu * NWAVES + F.wave, NGW = F.G * NWAVES;
    const float* MODL = (const float*)(F.ws + WS_MOD) + (size_t)l * 3 * 12288;
    const float* R1 = (const float*)(F.ws + WS_R1); const bf16* Y = (const bf16*)(F.ws + WS_Y);
    const int* INV = (const int*)(F.ws + WS_INV);
    const float* GATE = (const float*)(F.ws + WS_GATE); const float* GATEC = (const float*)(F.ws + WS_GATEC);
    const float* lw = F.ln_w + (size_t)(l * 2 + 1) * DM; const float* lbp = F.ln_b + (size_t)(l * 2 + 1) * DM;
    const int le = F.lane & 15;
    int nslot = -1; float ngate = 0.f; f32x4 nx[8];
#define CB_FETCH(r_) do { const int r__ = (r_); const bool lat__ = r__ < NLAT; const int b__ = lat__ ? (r__ >> 13) : ((r__ - NLAT) >> 8); \
        nslot = INV[(size_t)r__ * 16 + le]; \
        ngate = nslot >= 0 ? (lat__ ? GATE[(b__ * NEXP + le) * CAP + nslot] : GATEC[(b__ * NEXP + le) * CAPC + nslot]) : 0.f; \
        const float* xr__ = R1 + (size_t)r__ * DM; _Pragma("unroll") for (int j = 0; j < 8; ++j) nx[j] = *(const f32x4*)(xr__ + 256 * j + 4 * F.lane); } while (0)
    if (gw < nrows) CB_FETCH(gw);
    for (int row = gw; row < nrows; row += NGW) {
        const bool lat = row < NLAT; const int brow = lat ? (row >> 13) : 2; const int b = lat ? (row >> 13) : ((row - NLAT) >> 8);
        f32x4 moe[8];
#pragma unroll
        for (int j = 0; j < 8; ++j) moe[j] = (f32x4){0.f, 0.f, 0.f, 0.f};
        const int myslot = nslot; const float mygate = ngate; f32x4 xcur[8];
#pragma unroll
        for (int j = 0; j < 8; ++j) xcur[j] = nx[j];
        if (row + NGW < nrows) CB_FETCH(row + NGW);
        unsigned long long mask = __ballot(myslot >= 0 && F.lane < 16);
        while (mask) {
            const int e0 = __builtin_ctzll(mask); mask &= mask - 1;
            const bool two = mask != 0; const int e1 = two ? __builtin_ctzll(mask) : e0; if (two) mask &= mask - 1;
            const int s0 = __shfl(myslot, e0), s1 = __shfl(myslot, e1);
            const float g0 = __shfl(mygate, e0), g1 = two ? __shfl(mygate, e1) : 0.f;
            const size_t yr0 = lat ? (size_t)(e0 * 2048 + b * 1024 + s0) : (size_t)(XG_LAT_ROWS + e0 * 256 + b * 32 + s0);
            const size_t yr1 = lat ? (size_t)(e1 * 2048 + b * 1024 + s1) : (size_t)(XG_LAT_ROWS + e1 * 256 + b * 32 + s1);
            const bf16* yp0 = Y + yr0 * DM + 4 * F.lane; const bf16* yp1 = Y + yr1 * DM + 4 * F.lane;
            v2u w0[8], w1[8];
#pragma unroll
            for (int j = 0; j < 8; ++j) { w0[j] = *(const v2u*)(yp0 + 256 * j); w1[j] = *(const v2u*)(yp1 + 256 * j); }
#pragma unroll
            for (int j = 0; j < 8; ++j) {
                moe[j][0] += g0 * bflo(w0[j].x); moe[j][1] += g0 * bfhi(w0[j].x); moe[j][2] += g0 * bflo(w0[j].y); moe[j][3] += g0 * bfhi(w0[j].y);
                moe[j][0] += g1 * bflo(w1[j].x); moe[j][1] += g1 * bfhi(w1[j].x); moe[j][2] += g1 * bflo(w1[j].y); moe[j][3] += g1 * bfhi(w1[j].y); }
        }
        const float* g2 = MODL + (size_t)brow * 12288 + 5 * DM;
        f32x4 v[8];
#pragma unroll
        for (int j = 0; j < 8; ++j) { const int cc = 256 * j + 4 * F.lane; v[j] = xcur[j] * ALPHA_RES + *(const f32x4*)(g2 + cc) * moe[j]; }
        ln_inplace(v, lw, lbp, F.lane);
        float* orow = lat ? F.out + (size_t)row * DM : (float*)(F.ws + WS_R2C) + (size_t)(row - NLAT) * DM;
#pragma unroll
        for (int j = 0; j < 8; ++j) *(f32x4*)(orow + 256 * j + 4 * F.lane) = v[j];
        if (l + 1 < DEPTH) { const float* MN = (const float*)(F.ws + WS_MOD) + (size_t)(l + 1) * 3 * 12288 + (size_t)brow * 12288;
            store_mod_bf16((bf16*)(F.ws + WS_XM) + (size_t)row * DM, v, MN, MN + DM, F.lane); }
    }
#undef CB_FETCH
}

#ifndef MK_ONE_LAUNCH
#define MK_ONE_LAUNCH 1
#endif
constexpr int NPHASE = 2 + 11 * DEPTH;
struct Args { const float* in[19]; float* out; unsigned char* ws; int ph_lo, ph_hi; };
__global__ void __launch_bounds__(NWAVES * 64, 2) mk_fwd(Args args) {
    extern __shared__ __attribute__((aligned(16))) unsigned char lds[];
    Frame F;
    F.lds = (LAS unsigned char*)lds; F.ldsg = (char*)lds;
    F.tid = threadIdx.x; F.lane = F.tid & 63; F.wave = __builtin_amdgcn_readfirstlane(F.tid >> 6);
    F.G = gridDim.x; { const int bx = blockIdx.x; F.vcu = (F.G % 8 == 0) ? (bx % 8) * (F.G / 8) + bx / 8 : bx; }
    F.ws = args.ws; F.out = args.out;
    F.x = args.in[0]; F.c = args.in[1]; F.ctx = args.in[2]; F.c_ctx = args.in[3]; F.w_mod = args.in[4]; F.b_mod = args.in[5]; F.w_in = args.in[6]; F.w_conv = args.in[7];
    F.lambda_qk = args.in[8]; F.subln_w = args.in[9]; F.lb_logits = args.in[10]; F.hgrn_norm_w = args.in[11]; F.w_out = args.in[12]; F.ln_w = args.in[13]; F.ln_b = args.in[14];
    F.w_router = args.in[15]; F.w_gate = args.in[16]; F.w_up = args.in[17]; F.w_down = args.in[18];
    volatile LAS unsigned* MISC = (volatile LAS unsigned*)(F.lds + MISC_OFF);
    for (int u = F.tid; u < (LDS_BYTES - RING_BYTES) / 4; u += NWAVES * 64) ((LAS unsigned*)(F.lds + RING_BYTES))[u] = 0u;
    __syncthreads();
    const int lo = args.ph_lo, hi = args.ph_hi;
    const bool one = (hi - lo) > 1;
    XcdBarrier bar; bar.bar = (unsigned*)(F.ws + WS_CTL) + CW_BAR; bar.x = 0; bar.st = nullptr;
    if (one) bar = xcd_barrier_post((unsigned*)(F.ws + WS_CTL) + CW_BAR, MISC + 8);
#ifndef MK_MASK
#define MK_MASK 0xffffffffu
#endif
#define IN(k) (lo <= (k) && (k) < hi)
#define ON(j) ((MK_MASK >> (j)) & 1u)
#ifndef MK_REP
#define MK_REP 0u
#endif
#define NREP(j) (1 + (int)((MK_REP >> (j)) & 1u))
#ifndef MK_BAR2
#define MK_BAR2 0
#endif
#define SEAM(k) do { if (IN(k) && IN((k) + 1)) { xcd_barrier(bar); if (MK_BAR2) xcd_barrier(bar); } } while (0)
#define RELAUNDER() do { int t_ = threadIdx.x; asm volatile("" : "+v"(t_)); F.tid = t_; F.lane = t_ & 63; F.wave = __builtin_amdgcn_readfirstlane(t_ >> 6); } while (0)

    if (ON(11) && IN(0)) for (int rep_ = 0; rep_ < NREP(11); ++rep_) { RELAUNDER(); p0_prologue(F); } SEAM(0);
    if (ON(12) && IN(1)) for (int rep_ = 0; rep_ < NREP(12); ++rep_) { RELAUNDER(); p1_modulate(F); } SEAM(1);

    for (int l = 0; l < DEPTH; ++l) {
        const int pb = 2 + 11 * l;
        const bool need_ctx = (l + 1 < DEPTH);
        const float* MODL = (const float*)(F.ws + WS_MOD) + (size_t)l * 3 * 12288;
        if (ON(0) && IN(pb + 0)) for (int rep_ = 0; rep_ < NREP(0); ++rep_) { RELAUNDER();
            pg8::Gemm g{(const pg8::bf16_t*)(F.ws + WS_XM), (const pg8::bf16_t*)(F.ws + WS_WIN) + (size_t)l * PROJ_W * DM, MROWS, PROJ_W, DM};
            pg8::StaticOrder S; S.init(MROWS, PROJ_W, F.G, (int)blockIdx.x);
            pg8::EpiProj E{(pg8::bf16_t*)(F.ws + WS_QKV), (pg8::bf16_t*)(F.ws + WS_CG), (float*)(F.ws + WS_GF)};
            pg8::gemm_phase<pg8::EpiProj, pg8::StaticOrder, true, true>(F.lds, g, S, E);
            { const int nu = (MROWS / 256) * (PROJ_W / 256), extra = nu % F.G, bx = (int)blockIdx.x;
              if (extra == 0 || bx >= extra) { RELAUNDER(); deferred_convert(F, l == 0 ? 0 : CV_S4, l == 0 ? CV_S1 : CV_DEFER, extra == 0 ? bx : bx - extra, extra == 0 ? F.G : F.G - extra); } }
        }
        SEAM(pb + 0);
        if (ON(1) && IN(pb + 1)) for (int rep_ = 0; rep_ < NREP(1); ++rep_) { RELAUNDER();
            if (ON(13)) for (int r2_ = 0; r2_ < NREP(13); ++r2_) hg_h1_units(F, l);
            RELAUNDER(); if (ON(14)) for (int r2_ = 0; r2_ < NREP(14); ++r2_) conv_rows(F, l, need_ctx ? MROWS : NLAT);
            RELAUNDER(); if (ON(15)) for (int r2_ = 0; r2_ < NREP(15); ++r2_) {
            const float* lq = F.lambda_qk + (size_t)l * 4 * 64;
            const float s1 = wave_sum(lq[F.lane] * lq[64 + F.lane]), s2 = wave_sum(lq[128 + F.lane] * lq[192 + F.lane]);
            const float li = lambda_init_of(l), lam = expf(s1) - expf(s2) + li, post = 1.0f - li;
            const bf16* Q = (const bf16*)(F.ws + WS_QKV); const bf16* K = Q + (size_t)MROWS * 1024; const bf16* V = K + (size_t)MROWS * 1024;
            bf16* MIX = (bf16*)(F.ws + WS_MIX);
            const int nunits = 1024 + (need_ctx ? 32 : 0);
            __syncthreads();
            for (int i = 0;; ++i) { const int u = i * F.G + F.vcu; if (u >= nunits) break;
                if (u < 1024) { const int bh = u >> 6, qb = u & 63, b = bh >> 3, h = bh & 7; const size_t q0 = (size_t)b * SEQ + qb * 128;
                    att::attn_unit(Q + q0 * 1024 + h * 128, K + h * 128, V + h * 128, b * SEQ, 128, NLAT + b * CTXL, 132, lam, post, F.subln_w + l * 128, MIX + q0 * DM + h * 128, F.ldsg); }
                else { const int uc = u - 1024, bh = uc >> 1, qb = uc & 1, b = bh >> 3, h = bh & 7; const size_t q0 = (size_t)NLAT + b * CTXL + qb * 128;
                    att::attn_unit(Q + q0 * 1024 + h * 128, K + h * 128, V + h * 128, 0, 0, NLAT + b * CTXL, 4, lam, post, F.subln_w + l * 128, MIX + q0 * DM + h * 128, F.ldsg); } }
            }
        }
        SEAM(pb + 1);
        if (ON(2) && IN(pb + 2)) for (int rep_ = 0; rep_ < NREP(2); ++rep_) { RELAUNDER(); hg_h2(F); }
        SEAM(pb + 2);
        if (ON(3) && IN(pb + 3)) for (int rep_ = 0; rep_ < NREP(3); ++rep_) { RELAUNDER();
            unsigned* tick = (unsigned*)(F.ws + WS_CTL) + 8192 + 64 * l; volatile LAS unsigned* tk = (volatile LAS unsigned*)(F.lds + RING_BYTES + 64);
            const int nun = need_ctx ? 8 * NCHUNK : 8 * (NCHUNK - 4);
            for (;;) {
                if (F.tid == 0) *tk = __hip_atomic_fetch_add(tick, 1u, __ATOMIC_RELAXED, __HIP_MEMORY_SCOPE_AGENT);
                __syncthreads();
                const int t = (int)*tk;
                __syncthreads();
                if (t >= nun) break;
                const int u = need_ctx ? t : (t / (NCHUNK - 4)) * NCHUNK + 4 + t % (NCHUNK - 4);
                hg_h3_unit(F, l, u);
            } }
        SEAM(pb + 3);
        if (ON(4) && IN(pb + 4)) for (int rep_ = 0; rep_ < NREP(4); ++rep_) { RELAUNDER();
            const int M = need_ctx ? MROWS : NLAT;
            pg8::Gemm g{(const pg8::bf16_t*)(F.ws + WS_MIX), (const pg8::bf16_t*)(F.ws + WS_WOUT) + (size_t)l * DM * DM, M, DM, DM};
            pg8::StaticOrder S; S.init(M, DM, F.G, (int)blockIdx.x);
            pg8::EpiOut E{l == 0 ? F.x : (const float*)F.out, l == 0 ? F.ctx : (const float*)(F.ws + WS_R2C), (float*)(F.ws + WS_Z), MODL};
            pg8::gemm_phase<pg8::EpiOut, pg8::StaticOrder, true, true>(F.lds, g, S, E);
            if (l == 0) { const int nu = (M / 256) * (DM / 256), extra = nu % F.G, bx = (int)blockIdx.x;
              if (extra == 0 || bx >= extra) { RELAUNDER(); deferred_convert(F, CV_S1, CV_S2, extra == 0 ? bx : bx - extra, extra == 0 ? F.G : F.G - extra); } }
        }
        SEAM(pb + 4);
        if (ON(5) && IN(pb + 5)) for (int rep_ = 0; rep_ < NREP(5); ++rep_) { RELAUNDER(); ln1_router(F, l, need_ctx ? MROWS : NLAT); }
        SEAM(pb + 5);
        if (ON(6) && IN(pb + 6)) for (int rep_ = 0; rep_ < NREP(6); ++rep_) { RELAUNDER(); for (int u = blockIdx.x; u < (need_ctx ? 64 : 32); u += F.G) topk_unit(F, u); }
        SEAM(pb + 6);
        if (ON(8) && IN(pb + 8)) for (int rep_ = 0; rep_ < NREP(8); ++rep_) { RELAUNDER();
            pg8::Gemm g{(const pg8::bf16_t*)(F.ws + WS_XM), (const pg8::bf16_t*)(F.ws + WS_WGU) + (size_t)l * NEXP * 2048 * DM, XG_ROWS, NEXP * 2048, DM};
            pg8::MoeOrder S{F.G, (int)blockIdx.x, 1024 + (need_ctx ? 128 : 0)};
            pg8::EpiMoe1 E{(pg8::bf16_t*)(F.ws + WS_HID)};
            pg8::gemm_phase<pg8::EpiMoe1, pg8::MoeOrder, true, true, true>(F.lds, g, S, E, (const int*)(F.ws + WS_ROWSRC));
            if (l == 0) { const int extra = S.ntot % F.G, bx = (int)blockIdx.x;
              if (extra == 0 || bx >= extra) { RELAUNDER(); deferred_convert(F, CV_S2, CV_S3, extra == 0 ? bx : bx - extra, extra == 0 ? F.G : F.G - extra); } }
        }
        SEAM(pb + 8);
        if (ON(9) && IN(pb + 9)) for (int rep_ = 0; rep_ < NREP(9); ++rep_) { RELAUNDER();
            pg8::Gemm g{(const pg8::bf16_t*)(F.ws + WS_HID), (const pg8::bf16_t*)(F.ws + WS_WD) + (size_t)l * NEXP * DM * EFF, XG_ROWS, NEXP * 2048, EFF};
            pg8::MoeOrder S{F.G, (int)blockIdx.x, 1024 + (need_ctx ? 128 : 0)};
            pg8::EpiMoe2 E{(pg8::bf16_t*)(F.ws + WS_Y)};
            pg8::gemm_phase<pg8::EpiMoe2, pg8::MoeOrder, true, true>(F.lds, g, S, E);
            if (l == 0) { const int extra = S.ntot % F.G, bx = (int)blockIdx.x;
              if (extra == 0 || bx >= extra) { RELAUNDER(); deferred_convert(F, CV_S3, CV_S4, extra == 0 ? bx : bx - extra, extra == 0 ? F.G : F.G - extra); } }
        }
        SEAM(pb + 9);
        if (ON(10) && IN(pb + 10)) for (int rep_ = 0; rep_ < NREP(10); ++rep_) { RELAUNDER(); combine_ln2(F, l, need_ctx ? MROWS : NLAT); }
        SEAM(pb + 10);
    }
#undef IN
#undef SEAM
}

extern "C" void kernel_launch(void* const* d_in, const int* in_sizes, int n_in, void* d_out, int out_size, void* d_ws, size_t ws_size, hipStream_t stream) {
    static int grid = 0;
    if (grid == 0) {
        if (n_in != 19 || in_sizes[0] != NLAT * DM || out_size != NLAT * DM || ws_size < WS_END) { fprintf(stderr, "kernel_launch: shape mismatch (n_in %d, in0 %d, out %d, ws %zu, need %zu)\n", n_in, n_in > 0 ? in_sizes[0] : -1, out_size, ws_size, (size_t)WS_END); grid = -1; return; }
        int dev = 0, cus = 0, per_cu = 0;
        if (hipGetDevice(&dev) != hipSuccess || hipDeviceGetAttribute(&cus, hipDeviceAttributeMultiprocessorCount, dev) != hipSuccess) { grid = -1; return; }
        if (hipFuncSetAttribute((const void*)mk_fwd, hipFuncAttributeMaxDynamicSharedMemorySize, LDS_BYTES) != hipSuccess) { fprintf(stderr, "kernel_launch: hipFuncSetAttribute failed\n"); grid = -1; return; }
        if (hipOccupancyMaxActiveBlocksPerMultiprocessor(&per_cu, (const void*)mk_fwd, NWAVES * 64, LDS_BYTES) != hipSuccess || per_cu < 1) fprintf(stderr, "kernel_launch: occupancy query reports %d\n", per_cu);
        (void)hipGetLastError();
        grid = cus;
    }
    if (grid < 0) return;
    (void)hipMemsetAsync((char*)d_ws + WS_CTL, 0, CTL_ZERO_BYTES, stream);
    Args a{};
    for (int i = 0; i < 19; ++i) a.in[i] = (const float*)d_in[i];
    a.out = (float*)d_out; a.ws = (unsigned char*)d_ws;
#if MK_ONE_LAUNCH
    a.ph_lo = 0; a.ph_hi = NPHASE;
    hipLaunchKernelGGL(mk_fwd, dim3(grid), dim3(NWAVES * 64), LDS_BYTES, stream, a);
#else
    for (int p = 0; p < NPHASE; ++p) { a.ph_lo = p; a.ph_hi = p + 1; hipLaunchKernelGGL(mk_fwd, dim3(grid), dim3(NWAVES * 64), LDS_BYTES, stream, a); }
#endif
}
```

```cpp
#define MK_REP 0u

#include <hip/hip_runtime.h>
#include <cstdio>
#include <cstdint>

constexpr int DM = 2048, NBATCH = 2, SEQ = 8192, CTXL = 256, DEPTH = 2;
constexpr int NLAT = NBATCH * SEQ;
constexpr int NCTX = NBATCH * CTXL;
constexpr int MROWS = NLAT + NCTX;
constexpr int PROJ_W = 7168, ATT_W = 1024, CONV_W = 512, HG_W = 512;
constexpr int NEXP = 16, EFF = 1024, CAP = 1024, CAPC = 32;
constexpr int NCHUNK = 132;
constexpr int NSCAN = 16;
constexpr float ALPHA_RES = 1.4142135623730951f;
constexpr float LN_EPS = 1e-6f;
constexpr int XG_LAT_ROWS = NEXP * 2048;
constexpr int XG_ROWS = XG_LAT_ROWS + NEXP * 256;

namespace pg8 {
#define PG8_LAS __attribute__((address_space(3)))
typedef unsigned short bf16_t;
typedef short bf16x8 __attribute__((ext_vector_type(8)));
typedef float f32x4 __attribute__((ext_vector_type(4)));
typedef unsigned u32x4 __attribute__((ext_vector_type(4)));
constexpr int BM = 256, BK = 64, HALF = 128, HTB = HALF * BK * 2  , STAGE_BYTES = 8 * HTB, NXCD = 8, WGM = 8;

__host__ __device__ __forceinline__ int lds_byte(int r, int c) { const int st = (r >> 4) * 2 + (c >> 5), rr = r & 15, cc = c & 31, ob = rr * 64 + cc * 2; return st * 1024 + (ob ^ (((ob >> 9) & 1) << 5)); }
__host__ __device__ __forceinline__ void stage_rc(int b, int& R, int& C) { const int st = b / 1024, sb = b % 1024, swz = sb ^ (((sb >> 9) & 1) << 5); R = (st >> 1) * 16 + swz / 64; C = (st & 1) * 32 + (swz % 64) / 2; }
__host__ __device__ __forceinline__ int perm32(int rho) { const int n = rho >> 4, i = rho & 15; return 8 * (i >> 2) + 4 * n + (i & 3); }

struct Unit { int pm, pn; };
struct Gemm { const bf16_t* A; const bf16_t* Bt; int M, N, K; };

struct StaticOrder {
    int nM, nN, nwg, G, c;
    __host__ __device__ void init(int M, int N, int G_, int c_) { nM = M / BM; nN = N / BM; nwg = nM * nN; G = G_; c = c_; }
    __host__ __device__ bool next(int i, Unit& u) const {
        const long L = (long)i * G + c; if (L >= nwg) return false;
        int wgid = (int)L; { const int q = nwg / NXCD, r = nwg % NXCD, xcd = wgid % NXCD, off = wgid / NXCD; wgid = (xcd < r ? xcd * (q + 1) : r * (q + 1) + (xcd - r) * q) + off; }
        const int nig = WGM * nN, gid = wgid / nig, fm = gid * WGM, gsz = (nM - fm) < WGM ? (nM - fm) : WGM;
        u.pm = fm + ((wgid % nig) % gsz); u.pn = (wgid % nig) / gsz; return true;
    }
    __device__ __forceinline__ void a_ready(const Unit&) const {}
    __device__ __forceinline__ void done(const Unit&) const {}
};

__device__ __forceinline__ unsigned cvt_pk_bf16(float lo, float hi) { unsigned r; asm volatile("v_cvt_pk_bf16_f32 %0, %1, %2" : "=v"(r) : "v"(lo), "v"(hi)); return r; }

typedef unsigned u32x2 __attribute__((ext_vector_type(2)));
struct EpiProj {
    static constexpr bool PERM = false, AFTER_DRAIN = false;
    bf16_t* QKV;
    bf16_t* CG;
    float*  GF;
    __device__ __forceinline__ void operator()(const f32x4 (&acc)[2][2][4][2], const Unit& u, int wr, int wc, int fr, int fq) const {
        const int pn = u.pn;
        const int row0 = u.pm * BM + wr * 64 + fr;
        if (pn >= 24) {
            float* base = GF + (size_t)((pn - 24) >> 1) * ((size_t)MROWS * 512) + ((pn - 24) & 1) * 256 + wc * 32 + 4 * fq;
#pragma unroll
            for (int ai = 0; ai < 2; ++ai)
#pragma unroll
                for (int m = 0; m < 4; ++m) { float* rowp = base + (size_t)(row0 + ai * HALF + m * 16) * 512;
#pragma unroll
                    for (int bj = 0; bj < 2; ++bj)
#pragma unroll
                        for (int n = 0; n < 2; ++n) *(f32x4*)(rowp + bj * HALF + n * 16) = acc[ai][bj][m][n]; }
            return;
        }
        bf16_t* base; int ld; bool rope = false;
        if (pn < 12) { base = QKV + (size_t)(pn >> 2) * ((size_t)MROWS * 1024) + (pn & 3) * 256; ld = 1024; rope = (pn < 8) && (u.pm < 64); }
        else { base = CG + (size_t)((pn - 12) >> 1) * ((size_t)MROWS * 512) + ((pn - 12) & 1) * 256; ld = 512; }
        base += wc * 32 + 4 * fq;
        if (rope) {
            f32x4 inv;
#pragma unroll
            for (int j = 0; j < 4; ++j) inv[j] = exp2f(-(float)(4 * fq + j) * (13.287712379549449f / 16.0f));
#pragma unroll
            for (int ai = 0; ai < 2; ++ai)
#pragma unroll
                for (int m = 0; m < 4; ++m) { const int row = row0 + ai * HALF + m * 16; const int t = row & (SEQ - 1);
                    const float pos = (float)((wc & 1) ? (t & 63) : (t >> 6));
                    f32x4 cs, sn;
#pragma unroll
                    for (int j = 0; j < 4; ++j) { const float ang = pos * inv[j]; cs[j] = __cosf(ang); sn[j] = __sinf(ang); }
                    bf16_t* rowp = base + (size_t)row * ld;
#pragma unroll
                    for (int bj = 0; bj < 2; ++bj) { const f32x4 x1 = acc[ai][bj][m][0], x2 = acc[ai][bj][m][1];
                        const f32x4 o1 = x1 * cs - x2 * sn, o2 = x2 * cs + x1 * sn;
                        u32x2 w1, w2; w1.x = cvt_pk_bf16(o1[0], o1[1]); w1.y = cvt_pk_bf16(o1[2], o1[3]); w2.x = cvt_pk_bf16(o2[0], o2[1]); w2.y = cvt_pk_bf16(o2[2], o2[3]);
                        *(u32x2*)(rowp + bj * HALF) = w1; *(u32x2*)(rowp + bj * HALF + 16) = w2; } }
        } else {
#pragma unroll
            for (int ai = 0; ai < 2; ++ai)
#pragma unroll
                for (int m = 0; m < 4; ++m) { bf16_t* rowp = base + (size_t)(row0 + ai * HALF + m * 16) * ld;
#pragma unroll
                    for (int bj = 0; bj < 2; ++bj)
#pragma unroll
                        for (int n = 0; n < 2; ++n) { const f32x4 v = acc[ai][bj][m][n]; u32x2 w; w.x = cvt_pk_bf16(v[0], v[1]); w.y = cvt_pk_bf16(v[2], v[3]);
                            *(u32x2*)(rowp + bj * HALF + n * 16) = w; } }
        }
    }
};
struct EpiOut {
    static constexpr bool PERM = false, AFTER_DRAIN = false;
    const float* xin_lat; const float* xin_ctx; float* Z; const float* modl;
    __device__ __forceinline__ void operator()(const f32x4 (&acc)[2][2][4][2], const Unit& u, int wr, int wc, int fr, int fq) const {
        const int brow = u.pm < 32 ? 0 : (u.pm < 64 ? 1 : 2);
        const int row0 = u.pm * BM + wr * 64 + fr, col0 = u.pn * BM + wc * 32 + 4 * fq;
        const float* g1 = modl + (size_t)brow * 12288 + 4096 + col0;
        const float* xin = (u.pm < 64) ? xin_lat : (xin_ctx - (size_t)NLAT * DM);
        f32x4 gv[2][2];
#pragma unroll
        for (int bj = 0; bj < 2; ++bj)
#pragma unroll
            for (int n = 0; n < 2; ++n) gv[bj][n] = *(const f32x4*)(g1 + bj * HALF + n * 16);
#pragma unroll
        for (int ai = 0; ai < 2; ++ai)
#pragma unroll
            for (int m2 = 0; m2 < 4; m2 += 2) { f32x4 xv[2][2][2];
#pragma unroll
                for (int mm = 0; mm < 2; ++mm) { const size_t off = (size_t)(row0 + ai * HALF + (m2 + mm) * 16) * DM + col0;
#pragma unroll
                    for (int bj = 0; bj < 2; ++bj)
#pragma unroll
                        for (int n = 0; n < 2; ++n) xv[mm][bj][n] = *(const f32x4*)(xin + off + bj * HALF + n * 16); }
#pragma unroll
                for (int mm = 0; mm < 2; ++mm) { const size_t off = (size_t)(row0 + ai * HALF + (m2 + mm) * 16) * DM + col0;
#pragma unroll
                    for (int bj = 0; bj < 2; ++bj)
#pragma unroll
                        for (int n = 0; n < 2; ++n) *(f32x4*)(Z + off + bj * HALF + n * 16) = xv[mm][bj][n] * ALPHA_RES + gv[bj][n] * acc[ai][bj][m2 + mm][n]; }
                asm volatile("" ::: "memory"); }
    }
};
__device__ __forceinline__ float silu_f(float a) { return a * __builtin_amdgcn_rcpf(1.0f + __expf(-a)); }
struct EpiMoe1 {
    static constexpr bool PERM = true, AFTER_DRAIN = false;
    bf16_t* H;
    __device__ __forceinline__ void operator()(const f32x4 (&acc)[2][2][4][2], const Unit& u, int wr, int wc, int fr, int fq) const {
        const int row0 = u.pm * BM + wr * 64 + fr, col0 = (u.pn & 7) * 128 + wc * 32 + 8 * fq;
#pragma unroll
        for (int ai = 0; ai < 2; ++ai)
#pragma unroll
            for (int m = 0; m < 4; ++m) { bf16_t* rowp = H + (size_t)(row0 + ai * HALF + m * 16) * EFF + col0;
                const f32x4 g0 = acc[ai][0][m][0], g1 = acc[ai][0][m][1], u0 = acc[ai][1][m][0], u1 = acc[ai][1][m][1];
                f32x4 h0, h1;
#pragma unroll
                for (int j = 0; j < 4; ++j) { h0[j] = silu_f(g0[j]) * u0[j]; h1[j] = silu_f(g1[j]) * u1[j]; }
                u32x4 w; w.x = cvt_pk_bf16(h0[0], h0[1]); w.y = cvt_pk_bf16(h0[2], h0[3]); w.z = cvt_pk_bf16(h1[0], h1[1]); w.w = cvt_pk_bf16(h1[2], h1[3]);
                *(u32x4*)rowp = w; }
    }
};
struct EpiMoe2 {
    static constexpr bool PERM = true, AFTER_DRAIN = false;
    bf16_t* Y;
    __device__ __forceinline__ void operator()(const f32x4 (&acc)[2][2][4][2], const Unit& u, int wr, int wc, int fr, int fq) const {
        const int row0 = u.pm * BM + wr * 64 + fr, col0 = (u.pn & 7) * BM + wc * 32 + 8 * fq;
#pragma unroll
        for (int ai = 0; ai < 2; ++ai)
#pragma unroll
            for (int m = 0; m < 4; ++m) { bf16_t* rowp = Y + (size_t)(row0 + ai * HALF + m * 16) * DM + col0;
#pragma unroll
                for (int bj = 0; bj < 2; ++bj) { const f32x4 v0 = acc[ai][bj][m][0], v1 = acc[ai][bj][m][1];
                    u32x4 w; w.x = cvt_pk_bf16(v0[0], v0[1]); w.y = cvt_pk_bf16(v0[2], v0[3]); w.z = cvt_pk_bf16(v1[0], v1[1]); w.w = cvt_pk_bf16(v1[2], v1[3]);
                    *(u32x4*)(rowp + bj * HALF) = w; } }
    }
};
struct MoeOrder {
    int G, c, ntot;
    __device__ bool next(int i, Unit& u) const {
        const long L = (long)i * G + c; if (L >= ntot) return false;
        if (L < 1024) {
            if (G == 256) {
                const int x = c & 7, j = c >> 3, e = i * 4 + (x >> 1); u.pm = e * 8 + (x & 1) * 4 + (j & 3); u.pn = e * 8 + (j >> 2); }
            else { const int e = (int)L >> 6, r = (int)L & 63; u.pm = e * 8 + (r & 7); u.pn = e * 8 + (r >> 3); } }
        else { const int Lc = (int)L - 1024, e = Lc >> 3; u.pm = 128 + e; u.pn = e * 8 + (Lc & 7); }
        return true;
    }
    __device__ __forceinline__ void a_ready(const Unit&) const {}
    __device__ __forceinline__ void done(const Unit&) const {}
};

template <class Epi, class Sched, bool ALIGN_EPI = false, bool SP2 = false, bool GATHER = false>
__device__ __forceinline__ void gemm_phase(PG8_LAS unsigned char* lds, const Gemm g, const Sched& S, const Epi& E, const int* rowsrc = nullptr) {
    static_assert(!GATHER || SP2, "gathered A rows are wired into the SP2 loop only");
    int tid_l = threadIdx.x; asm volatile("" : "+v"(tid_l));
    const int tid = tid_l, wid = __builtin_amdgcn_readfirstlane(tid >> 6), lane = tid & 63, wr = wid >> 2, wc = wid & 3, fr = lane & 15, fq = lane >> 4;
    const int K = g.K, nt = K / BK;
    unsigned voffA[2], voffB[2];
#pragma unroll
    for (int i = 0; i < 2; ++i) { int R, C; stage_rc(tid * 16 + i * 8192, R, C); const int Rb = Epi::PERM ? ((R & ~31) + perm32(R & 31)) : R;
        voffA[i] = (unsigned)(R * K + C) * 2u; voffB[i] = (unsigned)(Rb * K + C) * 2u; }
    const size_t kstep = (size_t)(BK * 2);
    const size_t hstep = (size_t)HALF * K * 2;
    const size_t tstep = 2 * hstep;
    const unsigned ldsw = (unsigned)wid * 1024u;
    const int aoff = lds_byte(wr * 64 + fr, fq * 8), boff = lds_byte(wc * 32 + fr, fq * 8);
#define PG8_SA(b, h) (((b) * 2 + (h)) * HTB)
#define PG8_SB(b, h) ((4 + (b) * 2 + (h)) * HTB)
#define PG8_STAGE(bufoff, gbase, voff) do { _Pragma("unroll") for (int _i = 0; _i < 2; ++_i) \
        __builtin_amdgcn_global_load_lds((const unsigned*)((const char*)(gbase) + (voff)[_i]), (PG8_LAS unsigned*)(lds + (bufoff) + ldsw + _i * 8192), 16, 0, 0); } while (0)
#define PG8_GOFF(u_, go_) do { _Pragma("unroll") for (int _h = 0; _h < 2; ++_h) _Pragma("unroll") for (int _i = 0; _i < 2; ++_i) { int R_, C_; stage_rc(tid * 16 + _i * 8192, R_, C_); \
        go_[_h][_i] = (unsigned)rowsrc[(u_).pm * BM + _h * HALF + R_] * (unsigned)(K * 2) + (unsigned)(C_ * 2); } } while (0)
#define PG8_STAGE_A(bufoff, gbase, h_, nx_) do { if constexpr (GATHER) { _Pragma("unroll") for (int _i = 0; _i < 2; ++_i) { const unsigned o_ = (nx_) ? goffN[h_][_i] : goffC[h_][_i]; \
        __builtin_amdgcn_global_load_lds((const unsigned*)((const char*)(gbase) + o_), (PG8_LAS unsigned*)(lds + (bufoff) + ldsw + _i * 8192), 16, 0, 0); } } \
    else { PG8_STAGE(bufoff, (gbase) + (h_) * hstep, voffA); } } while (0)
#define PG8_LDA(dst, b, h) do { _Pragma("unroll") for (int m = 0; m < 4; ++m) _Pragma("unroll") for (int k = 0; k < 2; ++k) dst[m][k] = *(const PG8_LAS bf16x8*)(lds + PG8_SA(b, h) + aoff + m * 2048 + k * 1024); } while (0)
#define PG8_LDB(dst, b, h) do { _Pragma("unroll") for (int n = 0; n < 2; ++n) _Pragma("unroll") for (int k = 0; k < 2; ++k) dst[n][k] = *(const PG8_LAS bf16x8*)(lds + PG8_SB(b, h) + boff + n * 2048 + k * 1024); } while (0)
#define PG8_MMA(ai, bj, At, Bt) do { __builtin_amdgcn_s_setprio(1); _Pragma("unroll") for (int m = 0; m < 4; ++m) _Pragma("unroll") for (int n = 0; n < 2; ++n) _Pragma("unroll") for (int k = 0; k < 2; ++k) \
        acc[ai][bj][m][n] = __builtin_amdgcn_mfma_f32_16x16x32_bf16(Bt[n][k], At[m][k], acc[ai][bj][m][n], 0, 0, 0); __builtin_amdgcn_s_setprio(0); } while (0)
#define PG8_WAIT_V(n) asm volatile("s_waitcnt vmcnt(" #n ")" ::: "memory")
#define PG8_WAIT_L(n) asm volatile("s_waitcnt lgkmcnt(" #n ")" ::: "memory")
#define PG8_BAR __builtin_amdgcn_s_barrier()
#define PG8_SCHED __builtin_amdgcn_sched_barrier(0)
    Unit cur, nxt; int ui = 0;
    if (!S.next(0, cur)) return;
    f32x4 acc[2][2][4][2];
#pragma unroll
    for (int a = 0; a < 2; ++a)
#pragma unroll
        for (int b = 0; b < 2; ++b)
#pragma unroll
            for (int m = 0; m < 4; ++m)
#pragma unroll
                for (int n = 0; n < 2; ++n) acc[a][b][m][n] = (f32x4){0.f, 0.f, 0.f, 0.f};
    bf16x8 At[4][2], B0[2][2], B1[2][2];
    const char* cA = GATHER ? (const char*)g.A : (const char*)g.A + (size_t)cur.pm * tstep; const char* cB = (const char*)g.Bt + (size_t)cur.pn * tstep;
    unsigned goffC[2][2] = {{0u, 0u}, {0u, 0u}}, goffN[2][2] = {{0u, 0u}, {0u, 0u}};
    if constexpr (GATHER) { PG8_GOFF(cur, goffC); }
    S.a_ready(cur);
    if constexpr (SP2) {
        PG8_STAGE(PG8_SB(0, 0), cB, voffB); PG8_STAGE(PG8_SB(0, 1), cB + hstep, voffB); PG8_STAGE_A(PG8_SA(0, 0), cA, 0, false); PG8_STAGE_A(PG8_SA(0, 1), cA, 1, false);
        if (wr == 1) PG8_BAR;
        PG8_WAIT_V(2); PG8_BAR;
        PG8_STAGE(PG8_SB(1, 0), cB + kstep, voffB); PG8_STAGE_A(PG8_SA(1, 0), cA + kstep, 0, false); PG8_STAGE(PG8_SB(1, 1), cB + hstep + kstep, voffB);
        PG8_WAIT_V(6); PG8_BAR;
    } else {
        PG8_STAGE(PG8_SB(0, 0), cB, voffB); PG8_STAGE(PG8_SA(0, 0), cA, voffA); PG8_STAGE(PG8_SB(0, 1), cB + hstep, voffB); PG8_STAGE(PG8_SA(0, 1), cA + hstep, voffA);
        if (wr == 1) PG8_BAR;
        PG8_WAIT_V(4); PG8_BAR;
        PG8_STAGE(PG8_SB(1, 0), cB + kstep, voffB); PG8_STAGE(PG8_SA(1, 0), cA + kstep, voffA); PG8_STAGE(PG8_SB(1, 1), cB + hstep + kstep, voffB);
        PG8_WAIT_V(6); PG8_BAR;
    }
    for (;;) {
        const bool has_next = S.next(ui + 1, nxt);
        const char* nA = GATHER ? cA : (has_next ? (const char*)g.A + (size_t)nxt.pm * tstep : cA);
        if constexpr (GATHER) { if (has_next) { PG8_GOFF(nxt, goffN); } else { _Pragma("unroll") for (int _h = 0; _h < 2; ++_h) _Pragma("unroll") for (int _i = 0; _i < 2; ++_i) goffN[_h][_i] = goffC[_h][_i]; } } const char* nB = has_next ? (const char*)g.Bt + (size_t)nxt.pn * tstep : cB;
        asm volatile(".p2align 8" ::: "memory");
        for (int t = 0; t < nt; t += 2) {
            const bool last = (t == nt - 2);
            const char* a1 = cA + (size_t)(t + 1) * kstep;
            const char* a2 = last ? nA : cA + (size_t)(t + 2) * kstep; const char* b2 = last ? nB : cB + (size_t)(t + 2) * kstep;
            const char* a3 = a2 + kstep; const char* b3 = b2 + kstep;
            if (last && has_next) S.a_ready(nxt);
            if constexpr (SP2) {
            PG8_LDB(B0, 0, 0); PG8_LDB(B1, 0, 1); PG8_SCHED; PG8_LDA(At, 0, 0); PG8_STAGE_A(PG8_SA(1, 1), a1, 1, false);
            PG8_WAIT_V(8); PG8_WAIT_L(0); PG8_BAR; PG8_MMA(0, 0, At, B0); PG8_MMA(0, 1, At, B1); PG8_BAR; PG8_SCHED;
            PG8_LDA(At, 0, 1); PG8_STAGE(PG8_SB(0, 0), b2, voffB); PG8_STAGE(PG8_SB(0, 1), b2 + hstep, voffB); PG8_STAGE_A(PG8_SA(0, 0), a2, 0, last);
            PG8_WAIT_V(8); PG8_WAIT_L(0); PG8_BAR; PG8_MMA(1, 0, At, B0); PG8_MMA(1, 1, At, B1); PG8_BAR; PG8_SCHED;
            PG8_LDB(B0, 1, 0); PG8_LDB(B1, 1, 1); PG8_SCHED; PG8_LDA(At, 1, 0); PG8_STAGE_A(PG8_SA(0, 1), a2, 1, last);
            PG8_WAIT_V(8); PG8_WAIT_L(0); PG8_BAR; PG8_MMA(0, 0, At, B0); PG8_MMA(0, 1, At, B1); PG8_BAR; PG8_SCHED;
            PG8_LDA(At, 1, 1); PG8_STAGE(PG8_SB(1, 0), b3, voffB); PG8_STAGE(PG8_SB(1, 1), b3 + hstep, voffB); PG8_STAGE_A(PG8_SA(1, 0), a3, 0, last);
            PG8_WAIT_V(8); PG8_WAIT_L(0); PG8_BAR; PG8_MMA(1, 0, At, B0); PG8_MMA(1, 1, At, B1); PG8_BAR; PG8_SCHED;
            } else {
            PG8_LDB(B0, 0, 0); PG8_SCHED; PG8_LDA(At, 0, 0); PG8_STAGE(PG8_SA(1, 1), a1 + hstep, voffA);
            PG8_WAIT_L(8); PG8_BAR; PG8_WAIT_L(0); PG8_MMA(0, 0, At, B0); PG8_BAR; PG8_SCHED;
            PG8_LDB(B1, 0, 1); PG8_STAGE(PG8_SB(0, 0), b2, voffB);
            PG8_BAR; PG8_WAIT_L(0); PG8_MMA(0, 1, At, B1); PG8_BAR;
            PG8_LDA(At, 0, 1); PG8_STAGE(PG8_SA(0, 0), a2, voffA);
            PG8_BAR; PG8_WAIT_L(0); PG8_MMA(1, 0, At, B0); PG8_BAR; PG8_SCHED;
            PG8_STAGE(PG8_SB(0, 1), b2 + hstep, voffB);
            PG8_WAIT_V(6); PG8_BAR; PG8_MMA(1, 1, At, B1); PG8_BAR;
            PG8_LDB(B0, 1, 0); PG8_SCHED; PG8_LDA(At, 1, 0); PG8_STAGE(PG8_SA(0, 1), a2 + hstep, voffA);
            PG8_WAIT_L(8); PG8_BAR; PG8_WAIT_L(0); PG8_MMA(0, 0, At, B0); PG8_BAR; PG8_SCHED;
            PG8_LDB(B1, 1, 1); PG8_STAGE(PG8_SB(1, 0), b3, voffB);
            PG8_BAR; PG8_WAIT_L(0); PG8_MMA(0, 1, At, B1); PG8_BAR;
            PG8_LDA(At, 1, 1); PG8_STAGE(PG8_SA(1, 0), a3, voffA);
            PG8_BAR; PG8_WAIT_L(0); PG8_MMA(1, 0, At, B0); PG8_BAR; PG8_SCHED;
            PG8_STAGE(PG8_SB(1, 1), b3 + hstep, voffB);
            PG8_WAIT_V(6); PG8_BAR; PG8_MMA(1, 1, At, B1); PG8_BAR;
            }
        }
        if constexpr (ALIGN_EPI) { if (wr == 0) PG8_BAR; }
        if constexpr (!Epi::AFTER_DRAIN) { E(acc, cur, wr, wc, fr, fq); S.done(cur); }
        if (!has_next) break;
#pragma unroll
        for (int a = 0; a < 2; ++a)
#pragma unroll
            for (int b = 0; b < 2; ++b)
#pragma unroll
                for (int m = 0; m < 4; ++m)
#pragma unroll
                    for (int n = 0; n < 2; ++n) acc[a][b][m][n] = (f32x4){0.f, 0.f, 0.f, 0.f};
        cur = nxt; cA = nA; cB = nB; ++ui;
        if constexpr (GATHER) { _Pragma("unroll") for (int _h = 0; _h < 2; ++_h) _Pragma("unroll") for (int _i = 0; _i < 2; ++_i) goffC[_h][_i] = goffN[_h][_i]; }
        if constexpr (ALIGN_EPI) { if (wr == 1) PG8_BAR; }
    }
    PG8_WAIT_V(0);
    if constexpr (!ALIGN_EPI) { if (wr == 0) PG8_BAR; }
    PG8_BAR;
    if constexpr (Epi::AFTER_DRAIN) { E.fused(acc, cur, wr, wc, fr, fq, lds, wid, lane); S.done(cur); }
#undef PG8_SA
#undef PG8_SB
#undef PG8_STAGE
#undef PG8_GOFF
#undef PG8_STAGE_A
#undef PG8_LDA
#undef PG8_LDB
#undef PG8_MMA
#undef PG8_WAIT_V
#undef PG8_WAIT_L
#undef PG8_BAR
#undef PG8_SCHED
}
}

constexpr size_t MiB = 1u << 20;
constexpr size_t WS_CTL = 0, CTL_ZERO_BYTES = 1 * MiB;
constexpr size_t WS_MOD = 1 * MiB;
constexpr size_t WS_RWT = WS_MOD + 512 * 1024;
constexpr size_t WS_AFF = 2 * MiB;
constexpr size_t WS_PART = WS_AFF;
constexpr size_t WS_AFFC = WS_AFF + (size_t)NBATCH * NEXP * SEQ * 4;
constexpr size_t WS_IDX = 4 * MiB;
constexpr size_t WS_IDXC = WS_IDX + 32 * 1024 * 4, WS_GATE = WS_IDXC + 32 * 32 * 4, WS_GATEC = WS_GATE + 32 * 1024 * 4;
constexpr size_t WS_ROWSRC = WS_IDX + 512 * 1024;
constexpr size_t WS_INV = 5 * MiB;
constexpr size_t WS_HD = 7 * MiB;
constexpr size_t WS_WIN = 10 * MiB;
constexpr size_t WS_WOUT = 66 * MiB;
constexpr size_t WS_WGU = 82 * MiB;
constexpr size_t WS_WD = 338 * MiB;
constexpr size_t WS_R1 = 466 * MiB;
constexpr size_t WS_R2C = 598 * MiB;
constexpr size_t WS_XM = 602 * MiB;
constexpr size_t WS_STAGE = 668 * MiB;
constexpr size_t WS_QKV = WS_STAGE;
constexpr size_t WS_CG = WS_QKV + 3 * (size_t)MROWS * 1024 * 2;
constexpr size_t WS_GF = WS_CG + 6 * (size_t)MROWS * 512 * 2;
constexpr size_t WS_MIX = WS_GF + 2 * (size_t)MROWS * 512 * 4;
constexpr size_t WS_HU = WS_MIX + (size_t)MROWS * 2048 * 2;
constexpr size_t WS_HS = WS_HU + (size_t)NSCAN * NCHUNK * 16384 * 4;
constexpr size_t WS_STAGE_END = WS_HS + (size_t)NSCAN * NCHUNK * 16384 * 2;
constexpr size_t WS_Z = WS_R1;
constexpr size_t WS_XG = WS_STAGE;
constexpr size_t WS_HID = WS_XG + (size_t)XG_ROWS * 2048 * 2;
constexpr size_t WS_Y = WS_HID + (size_t)XG_ROWS * 1024 * 2;
constexpr size_t WS_MOE_END = WS_Y + (size_t)XG_ROWS * 2048 * 2;
constexpr size_t WS_END = WS_STAGE_END > WS_MOE_END ? WS_STAGE_END : WS_MOE_END;
static_assert(WS_WIN + (size_t)DEPTH * PROJ_W * DM * 2 <= WS_WOUT && WS_WOUT + (size_t)DEPTH * DM * DM * 2 <= WS_WGU && WS_WGU + (size_t)DEPTH * NEXP * 2048 * 2048 * 2 <= WS_WD &&
              WS_WD + (size_t)DEPTH * NEXP * 2048 * 1024 * 2 <= WS_R1 && WS_R1 + (size_t)MROWS * DM * 4 <= WS_R2C && WS_R2C + (size_t)NCTX * DM * 4 <= WS_XM && WS_XM + (size_t)MROWS * DM * 2 <= WS_STAGE, "d_ws map");
static_assert(WS_PART + (size_t)DEPTH * 16 * 3 * 12288 * 4 <= WS_HD && WS_AFFC + (size_t)NBATCH * NEXP * CTXL * 4 <= WS_IDX && WS_GATEC + 32 * 32 * 4 <= WS_INV && WS_INV + (size_t)MROWS * 16 * 4 <= WS_HD && WS_HD + (size_t)NSCAN * NCHUNK * 128 * 4 <= WS_WIN, "d_ws small map");
static_assert(WS_END <= (size_t)1236 * MiB, "d_ws must fit in sum(inputs) = 1236.4 MiB");
constexpr int CW_BAR = 4096;

constexpr int RING_BYTES = 131072;
constexpr int MISC_OFF = RING_BYTES + 320;
constexpr int LDS_BYTES = 151552;
constexpr int SPARE_OFF = RING_BYTES + 1024;
constexpr int NWAVES = 8;

#define GAS __attribute__((address_space(1)))
#define LAS __attribute__((address_space(3)))
typedef unsigned short bf16;
typedef unsigned v4u __attribute__((ext_vector_type(4)));
typedef unsigned v2u __attribute__((ext_vector_type(2)));
typedef float f32x4 __attribute__((ext_vector_type(4)));
typedef float f32x2 __attribute__((ext_vector_type(2)));
typedef short bf16x8 __attribute__((ext_vector_type(8)));
#define LDS_WAIT() asm volatile("s_waitcnt lgkmcnt(0)" ::: "memory")
#define VM_WAIT() asm volatile("s_waitcnt vmcnt(0)" ::: "memory")
#define LDS_BARRIER() asm volatile("s_waitcnt lgkmcnt(0)\n\ts_barrier" ::: "memory")
__device__ __forceinline__ unsigned f2bf(float f) { unsigned u = __builtin_bit_cast(unsigned, f); return (u + 0x7fffu + ((u >> 16) & 1u)) >> 16; }
__device__ __forceinline__ unsigned pk2(float lo, float hi) { return f2bf(lo) | (f2bf(hi) << 16); }
__device__ __forceinline__ float bf2f(unsigned short b) { return __builtin_bit_cast(float, ((unsigned)b) << 16); }
__device__ __forceinline__ float bflo(unsigned w) { return __builtin_bit_cast(float, w << 16); }
__device__ __forceinline__ float bfhi(unsigned w) { return __builtin_bit_cast(float, w & 0xffff0000u); }
__device__ __forceinline__ float wave_sum(float v) {
#pragma unroll
    for (int o = 1; o < 64; o <<= 1) v += __shfl_xor(v, o);
    return v;
}
__device__ __forceinline__ float sigmoid_f(float z) { return 1.0f / (1.0f + expf(-z)); }

#define XB_TMO      128
#define XB_XCNT(j)  (256  + 64 * (j))
#define XB_XSUB(j)  (1280 + 64 * (j))
#define XB_XGEN(j)  (2304 + 64 * (j))
#define XB_TOP      3328
#define XB_TOPGEN   3392
#define XCD_BAR_WORDS 3456
#define XB_SPIN_CAP (1u << 18)

__device__ __forceinline__ unsigned xb_ld(unsigned* p)              { return __hip_atomic_load(p, __ATOMIC_RELAXED, __HIP_MEMORY_SCOPE_AGENT); }
__device__ __forceinline__ unsigned xb_add(unsigned* p, unsigned v) { return __hip_atomic_fetch_add(p, v, __ATOMIC_RELAXED, __HIP_MEMORY_SCOPE_AGENT); }
__device__ __forceinline__ unsigned xb_xcc_id() { return (unsigned)__builtin_amdgcn_s_getreg((3 << 11) | 20) & 0xFu; }
#define XB_SPIN(cond, bar) do { unsigned _sp = 0; while (cond) { __builtin_amdgcn_s_sleep(1); \
    if ((++_sp & 255u) == 0u) { if (xb_ld(&(bar)[XB_TMO])) break; if (_sp > XB_SPIN_CAP) { atomicAdd(&(bar)[XB_TMO], 1u); break; } } } } while (0)

struct XcdBarrier {
    unsigned* bar; unsigned x;
    volatile LAS unsigned* st;
};

__device__ __forceinline__ XcdBarrier xcd_barrier_post(unsigned* bar, volatile LAS unsigned* st) {
    XcdBarrier b; b.bar = bar; b.x = xb_xcc_id(); b.st = st;
    if (threadIdx.x == 0) (void)xb_add(&bar[XB_XCNT(b.x)], 1u);
    return b;
}
__device__ __forceinline__ void xcd_barrier_complete(unsigned* bar, unsigned x, unsigned& nloc, unsigned& nx) {
    const unsigned G = gridDim.x * gridDim.y * gridDim.z;
    unsigned sum, cnt, mine, sp = 0u;
    for (;;) {
        sum = 0u; cnt = 0u; mine = 0u;
#pragma unroll
        for (unsigned j = 0; j < 16; ++j) { const unsigned c = xb_ld(&bar[XB_XCNT(j)]); sum += c; cnt += (c > 0u) ? 1u : 0u; mine = (j == x) ? c : mine; }
        if (sum == G) break;
        __builtin_amdgcn_s_sleep(1);
        if ((++sp & 255u) == 0u) { if (xb_ld(&bar[XB_TMO])) break; if (sp > XB_SPIN_CAP) { atomicAdd(&bar[XB_TMO], 1u); break; } }
    }
    nloc = mine > 0u ? mine : 1u; nx = cnt > 0u ? cnt : 1u;
}

__device__ __forceinline__ void xcd_barrier(const XcdBarrier& b) {
    asm volatile("s_waitcnt vmcnt(0)" ::: "memory");
    __syncthreads();
    if (threadIdx.x == 0) {
        unsigned* bar = b.bar;
        __builtin_amdgcn_s_waitcnt(0);
        unsigned nloc = b.st[0], nx = b.st[1];
        if (nloc == 0u) { xcd_barrier_complete(bar, b.x, nloc, nx); b.st[0] = nloc; b.st[1] = nx; }
        const unsigned old = xb_add(&bar[XB_XSUB(b.x)], 1u);
        const unsigned gen = old / nloc;
        if (old + 1u == (gen + 1u) * nloc) {
            __builtin_amdgcn_fence(__ATOMIC_RELEASE, "agent");
            asm volatile("s_waitcnt vmcnt(0)" ::: "memory");
            const unsigned og = xb_add(&bar[XB_TOP], 1u);
            const unsigned tg = og / nx;
            if (og + 1u == (tg + 1u) * nx) xb_add(&bar[XB_TOPGEN], 1u);
            else XB_SPIN(xb_ld(&bar[XB_TOPGEN]) == tg, bar);
            __builtin_amdgcn_fence(__ATOMIC_ACQUIRE, "agent");
            xb_add(&bar[XB_XGEN(b.x)], 1u);
            asm volatile("s_waitcnt vmcnt(0)" ::: "memory");
        } else {
            XB_SPIN(xb_ld(&bar[XB_XGEN(b.x)]) == gen, bar);
            __builtin_amdgcn_fence(__ATOMIC_ACQUIRE, "agent");
            asm volatile("s_waitcnt vmcnt(0)" ::: "memory");
        }
    }
    __syncthreads();
}


namespace att {
typedef short s16x4 __attribute__((ext_vector_type(4)));
typedef float f32x16 __attribute__((ext_vector_type(16)));
typedef unsigned u32x4 __attribute__((ext_vector_type(4)));
constexpr int KVBLK = 64, LDK = 1024;
constexpr float SCALE = 0.125f;
constexpr float THR = 8.f;
constexpr int SHM_V = KVBLK * 128 * 2, SHM_K = KVBLK * 128 * 2, SHM_ATTN = 2 * SHM_V + 2 * SHM_K + NWAVES * 64 * 4;
#define KSWZ(row, colB) ((row) * 256 + ((colB) ^ (((row) & 7) << 4)))
#define SBAR() __builtin_amdgcn_sched_barrier(0)
__device__ __forceinline__ int crow(int r, int hi) { return (r & 3) + 8 * (r >> 2) + 4 * hi; }
__device__ __forceinline__ unsigned cvtpk(float lo, float hi) { unsigned r; asm volatile("v_cvt_pk_bf16_f32 %0, %1, %2" : "=v"(r) : "v"(lo), "v"(hi)); return r; }
__device__ __forceinline__ void partialSM(f32x16& p0, f32x16& p1, float& m_reg, float& mn, float& alpha) {
  constexpr float C = SCALE * 1.4426950408889634f;
  float pmax = p0[0]; for (int r = 1; r < 16; ++r) pmax = fmaxf(pmax, p0[r]); for (int r = 0; r < 16; ++r) pmax = fmaxf(pmax, p1[r]);
  { auto rr = __builtin_amdgcn_permlane32_swap(__float_as_uint(pmax), __float_as_uint(pmax), false, false);
    pmax = fmaxf(__uint_as_float(rr[0]), __uint_as_float(rr[1])); }
  if (__builtin_expect(__all(pmax - m_reg <= THR / SCALE), 1)) { mn = m_reg; alpha = 1.f; }
  else { mn = fmaxf(m_reg, pmax); alpha = __builtin_amdgcn_exp2f((m_reg - mn) * C); m_reg = mn; }
  float mnC = -mn * C;
  for (int r = 0; r < 16; ++r) p0[r] = fmaf(p0[r], C, mnC); for (int r = 0; r < 16; ++r) p1[r] = fmaf(p1[r], C, mnC);
  for (int r = 0; r < 16; ++r) p0[r] = __builtin_amdgcn_exp2f(p0[r]);
}
__device__ __forceinline__ void finishSM(f32x16& p0, f32x16& p1, float alpha, float& l_reg, bf16x8& pa0, bf16x8& pa1, bf16x8& pa2, bf16x8& pa3) {
  for (int r = 0; r < 16; ++r) p1[r] = __builtin_amdgcn_exp2f(p1[r]);
  float ps = 0; for (int r = 0; r < 16; ++r) ps += p0[r]; for (int r = 0; r < 16; ++r) ps += p1[r];
  { auto rr = __builtin_amdgcn_permlane32_swap(__float_as_uint(ps), __float_as_uint(ps), false, false);
    ps = __uint_as_float(rr[0]) + __uint_as_float(rr[1]); }
  l_reg = l_reg * alpha + ps;
#define PK4(P, BASE, OUT) do { unsigned a0 = cvtpk(P[BASE + 0], P[BASE + 1]), a1 = cvtpk(P[BASE + 2], P[BASE + 3]);   \
    unsigned b0 = cvtpk(P[BASE + 4], P[BASE + 5]), b1 = cvtpk(P[BASE + 6], P[BASE + 7]);                              \
    auto r0 = __builtin_amdgcn_permlane32_swap(a0, b0, false, false); auto r1 = __builtin_amdgcn_permlane32_swap(a1, b1, false, false); \
    u32x4 w = {r0[0], r1[0], r0[1], r1[1]}; OUT = *reinterpret_cast<bf16x8*>(&w); } while (0)
  PK4(p0, 0, pa0); PK4(p0, 8, pa1); PK4(p1, 0, pa2); PK4(p1, 8, pa3);
#undef PK4
}
__device__ __forceinline__ void kload(bf16x8 (&kf)[8], const char* Ks, int r32, int hi, int sb) {
#pragma unroll
  for (int d0 = 0; d0 < 4; ++d0) { const int cb = sb + (d0 * 16 + hi * 8) * 2;
    kf[2 * d0] = *reinterpret_cast<const bf16x8*>(Ks + KSWZ(r32, cb)); kf[2 * d0 + 1] = *reinterpret_cast<const bf16x8*>(Ks + KSWZ(32 + r32, cb)); }
}
__device__ __forceinline__ void kmma(f32x16& p0, f32x16& p1, const bf16x8 (&kf)[8], const bf16x8* qr) {
  asm volatile("s_waitcnt lgkmcnt(0)" ::: "memory"); SBAR();
  p0 = f32x16{}; p1 = f32x16{};
#pragma unroll
  for (int d0 = 0; d0 < 4; ++d0) { p0 = __builtin_amdgcn_mfma_f32_32x32x16_bf16(kf[2 * d0], qr[d0], p0, 0, 0, 0); p1 = __builtin_amdgcn_mfma_f32_32x32x16_bf16(kf[2 * d0 + 1], qr[d0], p1, 0, 0, 0); }
}
__device__ __forceinline__ void qkt(f32x16& p0, f32x16& p1, const char* Ks, const bf16x8* qr, int r32, int hi, int sb) {
  bf16x8 kf[8]; kload(kf, Ks, r32, hi, sb); SBAR(); kmma(p0, p1, kf, qr);
}
__device__ __forceinline__ int v_st(int k, int c) { const int kk = (k & ~0xC) | ((k & 4) << 1) | ((k & 8) >> 1); return ((kk >> 3) * 4 + (c >> 5)) * 512 + ((kk & 7) * 32 + (c & 31)) * 2; }
__device__ __forceinline__ int v_rd_base(int lane) { return ((lane & 3) << 3) | (((lane >> 2) & 3) << 6) | (((lane >> 4) & 1) << 5) | (((lane >> 5) & 1) << 8); }
constexpr int v_rd_off(int d0, int ks, int half) { return d0 * 512 + ks * 4096 + half * 2048; }
template <int OFF> __device__ __forceinline__ s16x4 tr_read(int vb) {
  s16x4 r; asm volatile("ds_read_b64_tr_b16 %0, %1 offset:%2" : "=&v"(r) : "v"(vb), "i"(OFF) : "memory"); return r;
}
struct VFrag { s16x4 l0, h0, l1, h1, l2, h2, l3, h3; };
template <int D0> __device__ __forceinline__ void v_frag_read(VFrag& f, int vb) {
  f.l0 = tr_read<v_rd_off(D0, 0, 0)>(vb); f.h0 = tr_read<v_rd_off(D0, 0, 1)>(vb); f.l1 = tr_read<v_rd_off(D0, 1, 0)>(vb); f.h1 = tr_read<v_rd_off(D0, 1, 1)>(vb);
  f.l2 = tr_read<v_rd_off(D0, 2, 0)>(vb); f.h2 = tr_read<v_rd_off(D0, 2, 1)>(vb); f.l3 = tr_read<v_rd_off(D0, 3, 0)>(vb); f.h3 = tr_read<v_rd_off(D0, 3, 1)>(vb);
}
__device__ __forceinline__ void pv_mma(f32x16& od, const VFrag& f, bf16x8 pa0, bf16x8 pa1, bf16x8 pa2, bf16x8 pa3) {
#define PK(L, H) (bf16x8){L[0], L[1], L[2], L[3], H[0], H[1], H[2], H[3]}
  od = __builtin_amdgcn_mfma_f32_32x32x16_bf16(pa0, PK(f.l0, f.h0), od, 0, 0, 0);
  od = __builtin_amdgcn_mfma_f32_32x32x16_bf16(pa1, PK(f.l1, f.h1), od, 0, 0, 0);
  od = __builtin_amdgcn_mfma_f32_32x32x16_bf16(pa2, PK(f.l2, f.h2), od, 0, 0, 0);
  od = __builtin_amdgcn_mfma_f32_32x32x16_bf16(pa3, PK(f.l3, f.h3), od, 0, 0, 0);
#undef PK
}
__device__ __forceinline__ void pv_d0(f32x16* o, int vb, bf16x8 pa0, bf16x8 pa1, bf16x8 pa2, bf16x8 pa3) {
  VFrag fa, fb;
  v_frag_read<0>(fa, vb);
  asm volatile("s_waitcnt lgkmcnt(0)" ::: "memory"); SBAR();
  v_frag_read<1>(fb, vb); SBAR();
  pv_mma(o[0], fa, pa0, pa1, pa2, pa3); SBAR();
  asm volatile("s_waitcnt lgkmcnt(0)" ::: "memory"); SBAR();
  v_frag_read<2>(fa, vb); SBAR();
  pv_mma(o[1], fb, pa0, pa1, pa2, pa3); SBAR();
  asm volatile("s_waitcnt lgkmcnt(0)" ::: "memory"); SBAR();
  v_frag_read<3>(fb, vb); SBAR();
  pv_mma(o[2], fa, pa0, pa1, pa2, pa3); SBAR();
  asm volatile("s_waitcnt lgkmcnt(0)" ::: "memory"); SBAR();
  pv_mma(o[3], fb, pa0, pa1, pa2, pa3);
}

constexpr int NKS = 3, NVS = 4, LDS_KR = 0, LDS_VR = NKS * SHM_K, LDS_WS = LDS_VR + NVS * SHM_V;
__device__ __forceinline__ void attn_unit(const bf16* __restrict__ Qb, const bf16* __restrict__ Kh, const bf16* __restrict__ Vh, int klat0, int nlt, int kctx0, int NT,
                                          float lam, float post, const float* __restrict__ subw, bf16* __restrict__ Ob, char* lds) {
  int tid_l = threadIdx.x; asm volatile("" : "+v"(tid_l));
  const int tid = tid_l, wid = __builtin_amdgcn_readfirstlane(tid >> 6), lane = tid & 63, r32 = lane & 31, hi = lane >> 5;
  const int sbr = wid >> 2, wq = wid & 3, sb = sbr * 128;
  char* K_lds = lds + LDS_KR; char* V_lds = lds + LDS_VR;
  float* ws = (float*)(lds + LDS_WS) + wid * 64; float* li_l = ws; float* al_l = ws + 32;
  float m_reg = -1e30f, l_reg = 0; f32x16 o[4] = {}; bf16x8 qr[4];
  const bf16* Qw = Qb + (long)(wq * 32 + r32) * LDK + sbr * 64 + hi * 8;
#pragma unroll
  for (int d0 = 0; d0 < 4; ++d0) qr[d0] = *reinterpret_cast<const bf16x8*>(Qw + d0 * 16);
  unsigned koff[2], voff[2];
#pragma unroll
  for (int q = 0; q < 2; ++q) { const int ch = (q * 8 + wid) * 64 + lane;
    { const int row = ch >> 4, cpos = ch & 15, csrc = cpos ^ (row & 7); koff[q] = (unsigned)(row * LDK + csrc * 8) * 2u; }
    { const int pb = ch * 16, sub = pb >> 9, within = (pb & 511) >> 1, kk = (sub >> 2) * 8 + (within >> 5), c = (sub & 3) * 32 + (within & 31);
      const int k = (kk & ~0xC) | ((kk & 4) << 1) | ((kk & 8) >> 1); voff[q] = (unsigned)(k * LDK + c) * 2u; } }
  const int vb0 = (int)(uintptr_t)V_lds + v_rd_base(lane);
  const unsigned ldsw = (unsigned)wid * 1024u;
  typedef __attribute__((address_space(3))) unsigned lds_u32;
#define KROW(jt) ((jt) < nlt ? (long)klat0 + (long)(jt) * KVBLK : (long)kctx0 + (long)((jt) - nlt) * KVBLK)
#define DMA_TILE(jt) do { const long kb_ = KROW(jt) * (LDK * 2); const char* kg_ = (const char*)Kh + kb_; const char* vg_ = (const char*)Vh + kb_; \
    const unsigned ks_ = (unsigned)(((jt) % NKS) * SHM_K) + ldsw, vs_ = (unsigned)(LDS_VR + ((jt) % NVS) * SHM_V) + ldsw; \
    _Pragma("unroll") for (int q_ = 0; q_ < 2; ++q_) { \
      __builtin_amdgcn_global_load_lds((const unsigned*)(kg_ + koff[q_]), (lds_u32*)(uintptr_t)((unsigned)(uintptr_t)lds + ks_ + q_ * 8192u), 16, 0, 0); \
      __builtin_amdgcn_global_load_lds((const unsigned*)(vg_ + voff[q_]), (lds_u32*)(uintptr_t)((unsigned)(uintptr_t)lds + vs_ + q_ * 8192u), 16, 0, 0); } } while (0)
#define TILE_BAR(n) do { asm volatile("s_waitcnt vmcnt(" #n ")" ::: "memory"); __builtin_amdgcn_s_barrier(); asm volatile("" ::: "memory"); } while (0)
#define RESC(a) do { if (__any((a) < 1.f)) { if (hi == 0) al_l[r32] = (a); asm volatile("s_waitcnt lgkmcnt(0)" ::: "memory"); \
    for (int d = 0; d < 4; ++d) for (int r = 0; r < 16; ++r) o[d][r] *= al_l[crow(r, hi)]; } } while (0)
#define KS(jt) (K_lds + ((jt) % NKS) * SHM_K)
#define VB(jt) (vb0 + ((jt) % NVS) * SHM_V)
  f32x16 pA0, pA1, pB0, pB1; float mnA, mnB, alA, alB; bf16x8 pa0, pa1, pa2, pa3;
  DMA_TILE(0); DMA_TILE(1); TILE_BAR(4);
  DMA_TILE(2);
  qkt(pA0, pA1, KS(0), qr, r32, hi, sb); partialSM(pA0, pA1, m_reg, mnA, alA);
  TILE_BAR(4);
  if (sbr == 0) {
    asm volatile(".p2align 8" ::: "memory");
    for (int j = 1; j + 1 < NT; j += 2) {
      if (j + 2 < NT) DMA_TILE(j + 2);
      SBAR(); qkt(pB0, pB1, KS(j), qr, r32, hi, sb);
      finishSM(pA0, pA1, alA, l_reg, pa0, pa1, pa2, pa3); SBAR();
      pv_d0(o, VB(j - 1), pa0, pa1, pa2, pa3); partialSM(pB0, pB1, m_reg, mnB, alB);
      RESC(alB);
      if (j + 2 < NT) TILE_BAR(4); else TILE_BAR(0);
      if (j + 3 < NT) DMA_TILE(j + 3);
      SBAR(); qkt(pA0, pA1, KS(j + 1), qr, r32, hi, sb);
      finishSM(pB0, pB1, alB, l_reg, pa0, pa1, pa2, pa3); SBAR();
      pv_d0(o, VB(j), pa0, pa1, pa2, pa3); partialSM(pA0, pA1, m_reg, mnA, alA);
      RESC(alA);
      if (j + 3 < NT) TILE_BAR(4); else TILE_BAR(0);
    }
  } else {
    asm volatile(".p2align 8" ::: "memory");
    for (int j = 1; j + 1 < NT; j += 2) {
      if (j + 2 < NT) DMA_TILE(j + 2);
      bf16x8 kf[8];
      SBAR(); kload(kf, KS(j), r32, hi, sb); SBAR();
      finishSM(pA0, pA1, alA, l_reg, pa0, pa1, pa2, pa3); SBAR();
      kmma(pB0, pB1, kf, qr); SBAR();
      partialSM(pB0, pB1, m_reg, mnB, alB); SBAR();
      pv_d0(o, VB(j - 1), pa0, pa1, pa2, pa3);
      RESC(alB);
      if (j + 2 < NT) TILE_BAR(4); else TILE_BAR(0);
      if (j + 3 < NT) DMA_TILE(j + 3);
      SBAR(); kload(kf, KS(j + 1), r32, hi, sb); SBAR();
      finishSM(pB0, pB1, alB, l_reg, pa0, pa1, pa2, pa3); SBAR();
      kmma(pA0, pA1, kf, qr); SBAR();
      partialSM(pA0, pA1, m_reg, mnA, alA); SBAR();
      pv_d0(o, VB(j), pa0, pa1, pa2, pa3);
      RESC(alA);
      if (j + 3 < NT) TILE_BAR(4); else TILE_BAR(0);
    }
  }
  SBAR(); qkt(pB0, pB1, KS(NT - 1), qr, r32, hi, sb);
  finishSM(pA0, pA1, alA, l_reg, pa0, pa1, pa2, pa3); SBAR();
  pv_d0(o, VB(NT - 2), pa0, pa1, pa2, pa3); partialSM(pB0, pB1, m_reg, mnB, alB);
  RESC(alB);
  finishSM(pB0, pB1, alB, l_reg, pa0, pa1, pa2, pa3); SBAR();
  pv_d0(o, VB(NT - 1), pa0, pa1, pa2, pa3);
  if (hi == 0) li_l[r32] = l_reg; asm volatile("s_waitcnt lgkmcnt(0)" ::: "memory");
  int hi_e = hi, r32_e = r32, wq_e = wq;
  asm volatile("" : "+v"(hi_e), "+v"(r32_e), "+v"(wq_e));
  float rli[16];
#pragma unroll
  for (int r = 0; r < 16; ++r) rli[r] = 1.0f / li_l[crow(r, hi_e)];
#pragma unroll
  for (int d0 = 0; d0 < 4; ++d0)
#pragma unroll
    for (int r = 0; r < 16; ++r) o[d0][r] *= rli[r];
  asm volatile("s_waitcnt vmcnt(0)" ::: "memory");
  __syncthreads();
  float* X = (float*)lds;
  if (sbr == 1) {
#pragma unroll
    for (int d0 = 0; d0 < 4; ++d0)
#pragma unroll
      for (int r = 0; r < 16; ++r) X[(wq_e * 32 + crow(r, hi_e)) * 128 + d0 * 32 + r32_e] = o[d0][r];
  }
  __syncthreads();
  if (sbr == 0) {
    float sw[4];
#pragma unroll
    for (int d0 = 0; d0 < 4; ++d0) sw[d0] = subw[d0 * 32 + r32_e] * post;
    bf16* Ow = Ob + (long)(wq_e * 32) * DM;
#pragma unroll
    for (int r = 0; r < 16; ++r) { const int orow = crow(r, hi_e); float v[4]; float ss = 0.f;
#pragma unroll
      for (int d0 = 0; d0 < 4; ++d0) { v[d0] = o[d0][r] - lam * X[(wq_e * 32 + orow) * 128 + d0 * 32 + r32_e]; ss += v[d0] * v[d0]; }
      ss += __shfl_xor(ss, 1); ss += __shfl_xor(ss, 2); ss += __shfl_xor(ss, 4); ss += __shfl_xor(ss, 8); ss += __shfl_xor(ss, 16);
      const float rs = 1.0f / sqrtf(ss * (1.0f / 128.0f) + LN_EPS);
#pragma unroll
      for (int d0 = 0; d0 < 4; ++d0) Ow[(long)orow * DM + d0 * 32 + r32_e] = (bf16)f2bf(v[d0] * rs * sw[d0]); }
  }
  __syncthreads();
#undef KROW
#undef DMA_TILE
#undef TILE_BAR
#undef KS
#undef VB
#undef RESC
}
#undef KSWZ
}


struct Frame {
    LAS unsigned char* lds; char* ldsg;
    int tid, lane, wave, vcu, G;
    unsigned char* ws;
    const float *x, *c, *ctx, *c_ctx, *w_mod, *b_mod, *w_in, *w_conv, *lambda_qk, *subln_w, *lb_logits, *hgrn_norm_w, *w_out, *ln_w, *ln_b, *w_router, *w_gate, *w_up, *w_down;
    float* out;
};
__device__ __forceinline__ float lambda_init_of(int l) { return l == 0 ? 0.2f : 0.35550906759096926f; }

__device__ __forceinline__ void p0_transpose_item(const float* W, int K, int N, bf16* WT, int row_off, int mode, LAS float* scr, int item, int lane) {
    const int nblk = N / 32, kb = item / nblk, nb = item % nblk, k0 = 64 * kb, n0 = 32 * nb;
    float wv[32];
    const float* wp = W + (size_t)(k0 + (lane >> 5)) * N + n0 + (lane & 31);
#pragma unroll
    for (int i = 0; i < 32; ++i) wv[i] = wp[(size_t)(2 * i) * N];
#pragma unroll
    for (int i = 0; i < 32; ++i) { const int kk = 2 * i + (lane >> 5); scr[kk * 33 + (lane & 31)] = wv[i]; }
    LDS_WAIT(); asm volatile("" ::: "memory");
    const int cch = lane & 7;
#pragma unroll
    for (int j = 0; j < 4; ++j) { const int n = (lane >> 3) + 8 * j; const LAS float* s = scr + (8 * cch) * 33 + n;
        v4u o; o.x = pk2(s[0 * 33], s[1 * 33]); o.y = pk2(s[2 * 33], s[3 * 33]); o.z = pk2(s[4 * 33], s[5 * 33]); o.w = pk2(s[6 * 33], s[7 * 33]);
        const int nn = n0 + n; const int drow = mode ? (row_off + (nn >> 7) * 256 + (nn & 127)) : (row_off + nn);
        *(GAS v4u*)(WT + (size_t)drow * K + k0 + 8 * cch) = o; }
    LDS_WAIT(); asm volatile("" ::: "memory");
}
constexpr int CV_I_IN = (DM / 64) * (PROJ_W / 32), CV_I_OUT = (DM / 64) * (DM / 32), CV_I_GU = (DM / 64) * (EFF / 32), CV_I_DN = (EFF / 64) * (DM / 32);
constexpr int CV_N_IN = DEPTH * CV_I_IN, CV_N_OUT = DEPTH * CV_I_OUT, CV_N_G = DEPTH * NEXP * CV_I_GU, CV_N_D = DEPTH * NEXP * CV_I_DN;
constexpr int CV_NITEMS = CV_N_IN + CV_N_OUT + 2 * CV_N_G + CV_N_D;
constexpr int CV_DEFER0 = CV_I_IN + CV_I_OUT;
constexpr int CV_DEFER = 3 * NEXP * 1024;
constexpr int CV_S1 = 16000, CV_S2 = 33280, CV_S3 = 33280, CV_S4 = 33280;
static_assert(CV_I_GU == 1024 && CV_I_DN == 1024 && DEPTH == 2, "deferred-item numbering");
__device__ __forceinline__ void convert_item(Frame& F, int it) {
    LAS float* scr = (LAS float*)(F.lds + F.wave * 8704);
    bf16* WIN = (bf16*)(F.ws + WS_WIN); bf16* WOUT = (bf16*)(F.ws + WS_WOUT); bf16* WGU = (bf16*)(F.ws + WS_WGU); bf16* WD = (bf16*)(F.ws + WS_WD);
    int r = it;
    if (r < CV_N_IN) { const int l = r / CV_I_IN; p0_transpose_item(F.w_in + (size_t)l * DM * PROJ_W, DM, PROJ_W, WIN + (size_t)l * PROJ_W * DM, 0, 0, scr, r % CV_I_IN, F.lane); return; } r -= CV_N_IN;
    if (r < CV_N_OUT) { const int l = r / CV_I_OUT; p0_transpose_item(F.w_out + (size_t)l * DM * DM, DM, DM, WOUT + (size_t)l * DM * DM, 0, 0, scr, r % CV_I_OUT, F.lane); return; } r -= CV_N_OUT;
    if (r < CV_N_G) { const int le = r / CV_I_GU; p0_transpose_item(F.w_gate + (size_t)le * DM * EFF, DM, EFF, WGU + (size_t)le * 2048 * DM, 0, 1, scr, r % CV_I_GU, F.lane); return; } r -= CV_N_G;
    if (r < CV_N_G) { const int le = r / CV_I_GU; p0_transpose_item(F.w_up + (size_t)le * DM * EFF, DM, EFF, WGU + (size_t)le * 2048 * DM, 128, 1, scr, r % CV_I_GU, F.lane); return; } r -= CV_N_G;
    { const int le = r / CV_I_DN; p0_transpose_item(F.w_down + (size_t)le * EFF * DM, EFF, DM, WD + (size_t)le * DM * EFF, 0, 0, scr, r % CV_I_DN, F.lane); }
}
__device__ __forceinline__ bool cv_is_deferred(int it) {
    int r = it; if (r < CV_N_IN) return false; r -= CV_N_IN;
    if (r < CV_N_OUT) return false; r -= CV_N_OUT;
    if (r < CV_N_G) return r >= NEXP * 1024; r -= CV_N_G;
    if (r < CV_N_G) return r >= NEXP * 1024; r -= CV_N_G;
    return r >= NEXP * 1024;
}
__device__ __forceinline__ int cv_deferred_id(int b) {
    const int bb = b, t = bb / (NEXP * 1024), r = bb % (NEXP * 1024);
    return CV_N_IN + CV_N_OUT + t * CV_N_G + NEXP * 1024 + r;
}
__device__ __forceinline__ void deferred_convert(Frame& F, int lo, int hi, int rank, int nidle) {
    for (int b = lo + rank * NWAVES + F.wave; b < hi; b += nidle * NWAVES) convert_item(F, cv_deferred_id(b));
}
__device__ __forceinline__ void p0_prologue(Frame& F) {
    LAS float* sv = (LAS float*)(F.lds + 73728);
    LAS float* red = (LAS float*)(F.lds + 0);
    for (int i = F.tid; i < 3 * DM; i += 512) { const float v = (i < 2 * DM) ? F.c[i] : F.c_ctx[i - 2 * DM]; sv[i] = v / (1.0f + expf(-v)); }
    __syncthreads();
    float* PART = (float*)(F.ws + WS_PART);
    for (int it = blockIdx.x; it < DEPTH * 256; it += F.G) {
        const int l = it >> 8, ks = (it >> 4) & 15, ng = it & 15, k0 = 128 * ks + 16 * F.wave;
        const float* wb = F.w_mod + (size_t)l * DM * 12288 + (size_t)k0 * 12288 + 768 * ng;
        unsigned woff = (unsigned)(16 * F.lane); asm volatile("" : "+v"(woff));
        f32x4 acc[3][3];
#pragma unroll
        for (int r = 0; r < 3; ++r)
#pragma unroll
            for (int q = 0; q < 3; ++q) acc[r][q] = (f32x4){0.f, 0.f, 0.f, 0.f};
#pragma unroll
        for (int hf = 0; hf < 2; ++hf) { f32x4 wv[8][3];
#pragma unroll
            for (int i = 0; i < 8; ++i)
#pragma unroll
                for (int q = 0; q < 3; ++q) wv[i][q] = *(const f32x4*)((const char*)wb + (woff + (unsigned)(((8 * hf + i) * 12288 + 256 * q) * 4)));
#pragma unroll
            for (int i = 0; i < 8; ++i) { const int k = k0 + 8 * hf + i; const float s0 = sv[k], s1 = sv[DM + k], s2 = sv[2 * DM + k];
#pragma unroll
                for (int q = 0; q < 3; ++q) { acc[0][q] += wv[i][q] * s0; acc[1][q] += wv[i][q] * s1; acc[2][q] += wv[i][q] * s2; } } }
#pragma unroll
        for (int r = 0; r < 3; ++r)
#pragma unroll
            for (int q = 0; q < 3; ++q) *(LAS f32x4*)(red + (F.wave * 3 + r) * 768 + 256 * q + 4 * F.lane) = acc[r][q];
        __syncthreads();
        for (int o = F.tid; o < 3 * 192; o += 512) { const int r = o / 192, cidx = 4 * (o % 192); f32x4 sm = {0.f, 0.f, 0.f, 0.f};
#pragma unroll
            for (int w = 0; w < 8; ++w) sm += *(const LAS f32x4*)(red + (w * 3 + r) * 768 + cidx);
            *(f32x4*)(PART + ((size_t)((l * 16 + ks) * 3 + r)) * 12288 + 768 * ng + cidx) = sm; }
        __syncthreads();
    }
    { float* RWT = (float*)(F.ws + WS_RWT);
      for (int i = (int)blockIdx.x * 512 + F.tid; i < DEPTH * DM * NEXP; i += F.G * 512) { const int l = i >> 15, e = (i >> 11) & 15, cc = i & 2047;
          RWT[i] = F.w_router[(size_t)l * DM * NEXP + cc * NEXP + e]; } }
    const int gw = F.vcu * NWAVES + F.wave, NGW = F.G * NWAVES;
    for (int it = gw; it < CV_NITEMS; it += NGW) {
        if (cv_is_deferred(it)) continue;
        convert_item(F, it);
    }
}
__device__ __forceinline__ void store_mod_bf16(bf16* orow, const f32x4 (&v)[8], const float* sh, const float* sc, int lane) {
#pragma unroll
    for (int j = 0; j < 8; ++j) { const int c = 256 * j + 4 * lane; const f32x4 s1 = *(const f32x4*)(sc + c), s0 = *(const f32x4*)(sh + c);
        const f32x4 h = v[j] * (s1 + 1.0f) + s0; v2u w; w.x = pk2(h[0], h[1]); w.y = pk2(h[2], h[3]); *(v2u*)(orow + c) = w; }
}
__device__ __forceinline__ void store_mod_bf16_lds(bf16* orow, const f32x4 (&v)[8], const LAS float* sh, const LAS float* sc1p, int lane) {
#pragma unroll
    for (int j = 0; j < 8; ++j) { const int c = 256 * j + 4 * lane; const f32x4 s1 = *(const LAS f32x4*)(sc1p + c), s0 = *(const LAS f32x4*)(sh + c);
        const f32x4 h = v[j] * s1 + s0; v2u w; w.x = pk2(h[0], h[1]); w.y = pk2(h[2], h[3]); *(v2u*)(orow + c) = w; }
}
__device__ __forceinline__ void p1_modulate(Frame& F) {
    const int gw = F.vcu * NWAVES + F.wave, NGW = F.G * NWAVES;
    float* MOD = (float*)(F.ws + WS_MOD); bf16* XM = (bf16*)(F.ws + WS_XM);
    const float* PART = (const float*)(F.ws + WS_PART);
    for (int o = (int)blockIdx.x * 512 + F.tid; o < DEPTH * 3 * 12288 / 4; o += F.G * 512) { const int l = o / (3 * 3072), rn = o % (3 * 3072), r = rn / 3072, n = 4 * (rn % 3072);
        f32x4 sm = *(const f32x4*)(F.b_mod + (size_t)l * 12288 + n);
#pragma unroll
        for (int ks = 0; ks < 16; ++ks) sm += *(const f32x4*)(PART + ((size_t)((l * 16 + ks) * 3 + r)) * 12288 + n);
        *(f32x4*)(MOD + ((size_t)l * 3 + r) * 12288 + n) = sm; }
    LAS float* PSH = (LAS float*)(F.lds + 0); LAS float* PSC = PSH + 3 * DM;
    for (int i = F.tid; i < 3 * 1024; i += 512) { const int r = i / 1024, col = 4 * (i % 1024);
        f32x4 sm = *(const f32x4*)(F.b_mod + col);
#pragma unroll
        for (int ks = 0; ks < 16; ++ks) sm += *(const f32x4*)(PART + ((size_t)(ks * 3 + r)) * 12288 + col);
        if (col < DM) *(LAS f32x4*)(PSH + r * DM + col) = sm; else *(LAS f32x4*)(PSC + r * DM + (col - DM)) = sm + 1.0f; }
    __syncthreads();
    for (int row = gw; row < MROWS; row += NGW) {
        const int brow = row < NLAT ? (row >> 13) : 2;
        const float* xr = row < NLAT ? F.x + (size_t)row * DM : F.ctx + (size_t)(row - NLAT) * DM;
        f32x4 v[8];
#pragma unroll
        for (int j = 0; j < 8; ++j) v[j] = *(const f32x4*)(xr + 256 * j + 4 * F.lane);
        store_mod_bf16_lds(XM + (size_t)row * DM, v, PSH + brow * DM, PSC + brow * DM, F.lane);
    }
    __syncthreads();
}
__device__ __forceinline__ void ln_inplace(f32x4 (&v)[8], const float* w, const float* b, int lane) {
    float s = 0.f;
#pragma unroll
    for (int j = 0; j < 8; ++j) s += (v[j][0] + v[j][1]) + (v[j][2] + v[j][3]);
    const float mean = wave_sum(s) * (1.0f / DM); float q = 0.f;
#pragma unroll
    for (int j = 0; j < 8; ++j) { v[j] = v[j] - mean; q += (v[j][0] * v[j][0] + v[j][1] * v[j][1]) + (v[j][2] * v[j][2] + v[j][3] * v[j][3]); }
    const float rstd = 1.0f / sqrtf(wave_sum(q) * (1.0f / DM) + LN_EPS);
#pragma unroll
    for (int j = 0; j < 8; ++j) { const int c = 256 * j + 4 * lane; v[j] = v[j] * rstd * *(const f32x4*)(w + c) + *(const f32x4*)(b + c); }
}
__device__ __forceinline__ void ln_norm_only(f32x4 (&v)[8]) {
    float s = 0.f;
#pragma unroll
    for (int j = 0; j < 8; ++j) s += (v[j][0] + v[j][1]) + (v[j][2] + v[j][3]);
    const float mean = wave_sum(s) * (1.0f / DM); float q = 0.f;
#pragma unroll
    for (int j = 0; j < 8; ++j) { v[j] = v[j] - mean; q += (v[j][0] * v[j][0] + v[j][1] * v[j][1]) + (v[j][2] * v[j][2] + v[j][3] * v[j][3]); }
    const float rstd = 1.0f / sqrtf(wave_sum(q) * (1.0f / DM) + LN_EPS);
#pragma unroll
    for (int j = 0; j < 8; ++j) v[j] = v[j] * rstd;
}
__device__ __forceinline__ void ln_inplace_reg(f32x4 (&v)[8], const f32x4 (&w)[8], const f32x4 (&b)[8]) {
    float s = 0.f;
#pragma unroll
    for (int j = 0; j < 8; ++j) s += (v[j][0] + v[j][1]) + (v[j][2] + v[j][3]);
    const float mean = wave_sum(s) * (1.0f / DM); float q = 0.f;
#pragma unroll
    for (int j = 0; j < 8; ++j) { v[j] = v[j] - mean; q += (v[j][0] * v[j][0] + v[j][1] * v[j][1]) + (v[j][2] * v[j][2] + v[j][3] * v[j][3]); }
    const float rstd = 1.0f / sqrtf(wave_sum(q) * (1.0f / DM) + LN_EPS);
#pragma unroll
    for (int j = 0; j < 8; ++j) v[j] = v[j] * rstd * w[j] + b[j];
}
__device__ __forceinline__ void ln_inplace_lds(f32x4 (&v)[8], const LAS float* w, const LAS float* b, int lane) {
    float s = 0.f;
#pragma unroll
    for (int j = 0; j < 8; ++j) s += (v[j][0] + v[j][1]) + (v[j][2] + v[j][3]);
    const float mean = wave_sum(s) * (1.0f / DM); float q = 0.f;
#pragma unroll
    for (int j = 0; j < 8; ++j) { v[j] = v[j] - mean; q += (v[j][0] * v[j][0] + v[j][1] * v[j][1]) + (v[j][2] * v[j][2] + v[j][3] * v[j][3]); }
    const float rstd = 1.0f / sqrtf(wave_sum(q) * (1.0f / DM) + LN_EPS);
#pragma unroll
    for (int j = 0; j < 8; ++j) { const int c = 256 * j + 4 * lane; v[j] = v[j] * rstd * *(const LAS f32x4*)(w + c) + *(const LAS f32x4*)(b + c); }
}
__device__ __forceinline__ void conv_rows(Frame& F, int l, int nrows) {
    const int gw = F.vcu * NWAVES + F.wave, NGW = F.G * NWAVES;
    const bf16* CX = (const bf16*)(F.ws + WS_CG); const bf16* CB = CX + (size_t)MROWS * 512; const bf16* CC = CB + (size_t)MROWS * 512;
    bf16* MIX = (bf16*)(F.ws + WS_MIX);
    const float* wc = F.w_conv + (size_t)l * 3 * CONV_W + 8 * F.lane;
    float w0[8], w1[8], w2[8];
#pragma unroll
    for (int j = 0; j < 8; ++j) { w0[j] = wc[j]; w1[j] = wc[CONV_W + j]; w2[j] = wc[2 * CONV_W + j]; }
    for (int row = gw; row < nrows; row += NGW) {
        const int t = row < NLAT ? (row & (SEQ - 1)) : ((row - NLAT) & (CTXL - 1)); const int tl = row < NLAT ? SEQ - 1 : CTXL - 1;
        const size_t o = (size_t)row * 512 + 8 * F.lane;
        const v4u z4 = {0u, 0u, 0u, 0u};
        const v4u x1 = *(const v4u*)(CX + o), c1 = *(const v4u*)(CC + o), b1 = *(const v4u*)(CB + o);
        const v4u x0 = t > 0 ? *(const v4u*)(CX + o - 512) : z4, c0 = t > 0 ? *(const v4u*)(CC + o - 512) : z4;
        const v4u x2 = t < tl ? *(const v4u*)(CX + o + 512) : z4, c2 = t < tl ? *(const v4u*)(CC + o + 512) : z4;
        v4u ov;
#pragma unroll
        for (int q = 0; q < 4; ++q) {
            const float r0 = (bflo(c0[q]) * bflo(x0[q])) * w0[2 * q] + (bflo(c1[q]) * bflo(x1[q])) * w1[2 * q] + (bflo(c2[q]) * bflo(x2[q])) * w2[2 * q];
            const float r1 = (bfhi(c0[q]) * bfhi(x0[q])) * w0[2 * q + 1] + (bfhi(c1[q]) * bfhi(x1[q])) * w1[2 * q + 1] + (bfhi(c2[q]) * bfhi(x2[q])) * w2[2 * q + 1];
            ov[q] = pk2(bflo(b1[q]) * r0, bfhi(b1[q]) * r1); }
        *(v4u*)(MIX + (size_t)row * DM + ATT_W + 8 * F.lane) = ov;
    }
}
__device__ __forceinline__ void hg_rows(int b, int dir, int c, int& base, int& sgn) {
    if (dir == 0) { sgn = 1; base = (c < 4) ? (NLAT + b * CTXL + c * 64) : (b * SEQ + (c - 4) * 64); }
    else { sgn = -1; base = (c < 4) ? (NLAT + b * CTXL + CTXL - 1 - c * 64) : (b * SEQ + SEQ - 1 - (c - 4) * 64); }
}
__device__ __forceinline__ float hg_lb(const Frame& F, int l, int dir, int ch) {
    if (l == 0) return 0.f;
    const float x0 = F.lb_logits[(dir * DEPTH + 0) * HG_W + ch], x1 = F.lb_logits[(dir * DEPTH + 1) * HG_W + ch];
    return 1.0f / (1.0f + expf(x0 - x1));
}
typedef float f32x4v __attribute__((ext_vector_type(4)));
template <bool WITH_Q> __device__ __forceinline__ void hg_load(const float* zbuf, const bf16* GQ, const bf16* GI, int base, int sgn, int h, int d, int seg,
                                                              float (&z)[16], unsigned (&v)[16], unsigned (&q)[16]) {
    unsigned go = (unsigned)((base + sgn * (seg * 16)) * 512 + h * 128 + d) * 2u;
    asm volatile("" : "+v"(go));
    const unsigned st = (unsigned)(sgn * 1024);
#pragma unroll
    for (int j = 0; j < 16; ++j) { z[j] = *(const float*)((const char*)zbuf + 2u * go); v[j] = *(const bf16*)((const char*)GI + go);
        if (WITH_Q) q[j] = *(const bf16*)((const char*)GQ + go); go += st; }
}
__device__ __forceinline__ void hg_stage1(const float (&zz)[16], int d, int seg, float lb, LAS float* segs, float (&a)[16], float (&kin)[16], float& atot) {
    float run = 0.f;
#pragma unroll
    for (int j = 0; j < 16; ++j) { const float z = fminf(fmaxf(zz[j], -80.f), 80.f);
        const float sg = __builtin_amdgcn_rcpf(1.0f + __expf(-z)); const float f = lb + (1.0f - lb) * sg;
        run += __log2f(f); a[j] = run; kin[j] = (1.0f - lb) * (1.0f - sg); }
    segs[seg * 128 + d] = run;
    LDS_BARRIER();
    float off = 0.f, tot = 0.f;
#pragma unroll
    for (int s = 0; s < 4; ++s) { const float v = segs[s * 128 + d]; if (s < seg) off += v; tot += v; }
#pragma unroll
    for (int j = 0; j < 16; ++j) a[j] += off;
    atot = tot;
}
__device__ __forceinline__ void hg_h1_units(Frame& F, int l) {
    const int d = F.tid & 127, seg = F.tid >> 7, fr = F.lane & 15, fq = F.lane >> 4;
    LAS float* segs = (LAS float*)(F.lds + 0);
    LAS bf16* kdT = (LAS bf16*)(F.lds + 2048);
    LAS bf16* vT = (LAS bf16*)(F.lds + 2048 + 128 * 72 * 2);
    const bf16* GI = (const bf16*)(F.ws + WS_CG) + (size_t)4 * MROWS * 512;
    float z[16]; unsigned vv[16];
    int unit = blockIdx.x;
    if (unit < NSCAN * NCHUNK) { const int sc = unit / NCHUNK, c = unit % NCHUNK; int base, sgn; hg_rows((sc >> 2) & 1, sc >> 3, c, base, sgn);
        hg_load<false>((const float*)(F.ws + WS_GF) + (size_t)(sc >> 3) * MROWS * 512, GI, GI, base, sgn, sc & 3, d, seg, z, vv, vv); }
    for (; unit < NSCAN * NCHUNK; unit += F.G) {
        const int sc = unit / NCHUNK, dir = sc >> 3, h = sc & 3;
        const float lb = hg_lb(F, l, dir, h * 128 + d);
        float a[16], kin[16], atot;
        hg_stage1(z, d, seg, lb, segs, a, kin, atot);
        { v4u kp[2], vp[2];
#pragma unroll
          for (int j = 0; j < 16; j += 2) { const unsigned kw = pk2(kin[j] * __builtin_amdgcn_exp2f(atot - a[j]), kin[j + 1] * __builtin_amdgcn_exp2f(atot - a[j + 1]));
              const unsigned vw = (vv[j] & 0xffffu) | (vv[j + 1] << 16); kp[j >> 3][(j >> 1) & 3] = kw; vp[j >> 3][(j >> 1) & 3] = vw; }
          *(LAS v4u*)(kdT + d * 72 + seg * 16) = kp[0]; *(LAS v4u*)(kdT + d * 72 + seg * 16 + 8) = kp[1];
          *(LAS v4u*)(vT + d * 72 + seg * 16) = vp[0]; *(LAS v4u*)(vT + d * 72 + seg * 16 + 8) = vp[1]; }
        if (seg == 0) ((float*)(F.ws + WS_HD))[(size_t)unit * 128 + d] = __builtin_amdgcn_exp2f(atot);
        { const int un = unit + F.G;
          if (un < NSCAN * NCHUNK) { const int scn = un / NCHUNK, cn = un % NCHUNK; int basen, sgnn; hg_rows((scn >> 2) & 1, scn >> 3, cn, basen, sgnn);
              hg_load<false>((const float*)(F.ws + WS_GF) + (size_t)(scn >> 3) * MROWS * 512, GI, GI, basen, sgnn, scn & 3, d, seg, z, vv, vv); } }
        LDS_BARRIER();
        bf16x8 kf[2];
#pragma unroll
        for (int ks = 0; ks < 2; ++ks) kf[ks] = *(const LAS bf16x8*)(kdT + (F.wave * 16 + fr) * 72 + ks * 32 + fq * 8);
        bf16* UT = (bf16*)(F.ws + WS_HU) + (size_t)unit * 16384;
#pragma unroll
        for (int nt = 0; nt < 8; ++nt) { f32x4v acc = {0.f, 0.f, 0.f, 0.f};
#pragma unroll
            for (int ks = 0; ks < 2; ++ks) { const bf16x8 vf = *(const LAS bf16x8*)(vT + (nt * 16 + fr) * 72 + ks * 32 + fq * 8);
                acc = __builtin_amdgcn_mfma_f32_16x16x32_bf16(kf[ks], vf, acc, 0, 0, 0); }
            { v2u w; w.x = pk2(acc[0], acc[1]); w.y = pk2(acc[2], acc[3]); *(v2u*)(UT + (size_t)(nt * 16 + fr) * 128 + F.wave * 16 + fq * 4) = w; } }
        LDS_BARRIER();
    }
}
__device__ __forceinline__ void hg_h2(Frame& F) {
    const bf16* UT = (const bf16*)(F.ws + WS_HU); const float* HD = (const float*)(F.ws + WS_HD); bf16* HS = (bf16*)(F.ws + WS_HS);
    if (F.tid < 256) for (int e = (int)blockIdx.x * 256 + F.tid; e < NSCAN * 4096; e += F.G * 256) {
        const int sc = e >> 12, idx = (e & 4095) * 4, dk = idx & 127;
        const bf16* up = UT + (size_t)sc * NCHUNK * 16384 + idx; const float* dp = HD + (size_t)sc * NCHUNK * 128 + dk; bf16* sp = HS + (size_t)sc * NCHUNK * 16384 + idx;
        f32x4 S = {0.f, 0.f, 0.f, 0.f};
        for (int c0 = 0; c0 < NCHUNK; c0 += 12) {
            v2u u[12]; f32x4 dd[12];
#pragma unroll
            for (int k = 0; k < 12; ++k) { u[k] = *(const v2u*)(up + (size_t)(c0 + k) * 16384); dd[k] = *(const f32x4*)(dp + (c0 + k) * 128); }
#pragma unroll
            for (int k = 0; k < 12; ++k) { v2u w; w.x = pk2(S[0], S[1]); w.y = pk2(S[2], S[3]); *(v2u*)(sp + (size_t)(c0 + k) * 16384) = w;
                const f32x4 uf = {bflo(u[k].x), bfhi(u[k].x), bflo(u[k].y), bfhi(u[k].y)}; S = dd[k] * S + uf; }
        }
    }
}
#ifndef MK_HSEL
#define MK_HSEL (-1)
#endif
#define H3SEG(k) do { if (MK_HSEL >= 0 && blockIdx.x == 0 && threadIdx.x == 0) { volatile LAS unsigned* hs_ = (volatile LAS unsigned*)(F.lds + RING_BYTES + 128); const unsigned tn_ = (unsigned)__builtin_amdgcn_s_memrealtime(); if (MK_HSEL == (k)) hs_[0] += tn_ - hs_[1]; hs_[1] = tn_; } } while (0)
__device__ __forceinline__ void hg_h3_unit(Frame& F, int l, int unit) {
    const int bh = unit / NCHUNK, oc = unit % NCHUNK, b = bh >> 2, h = bh & 3;
    int t_l = F.tid; asm volatile("" : "+v"(t_l));
    const int d = t_l & 127, seg = __builtin_amdgcn_readfirstlane(t_l >> 7), fr = t_l & 15, fq = (t_l >> 4) & 3;
    LAS bf16* QT = (LAS bf16*)(F.lds + 0);
    LAS bf16* KT = (LAS bf16*)(F.lds + 17408);
    LAS bf16* vT = (LAS bf16*)(F.lds + 60928);
    LAS bf16* scS = (LAS bf16*)(F.lds + 79360);
    LAS float* OS = (LAS float*)(F.lds + 88576);
    LAS float* erho = (LAS float*)(F.lds + 121344);
    LAS float* segs = (LAS float*)(F.lds + 123392);
    const bf16* GQ = (const bf16*)(F.ws + WS_CG) + (size_t)3 * MROWS * 512; const bf16* GI = GQ + (size_t)MROWS * 512; const bf16* GG = GI + (size_t)MROWS * 512;
    float zin[16]; unsigned vin[16], qin[16];
    { int base, sgn; hg_rows(b, 0, oc, base, sgn); hg_load<true>((const float*)(F.ws + WS_GF), GQ, GI, base, sgn, h, d, seg, zin, vin, qin); }
    H3SEG(9);
    int base0, sg0; hg_rows(b, 0, oc, base0, sg0);
    const float lb_d0 = hg_lb(F, l, 0, h * 128 + d), lb_d1 = hg_lb(F, l, 1, h * 128 + d);
    unsigned gin0[8], gin1[8];
    for (int dir = 0; dir < 2; ++dir) {
        const int c = dir == 0 ? oc : (oc < 4 ? 3 - oc : 135 - oc);
        const int sc = dir * 8 + b * 4 + h;
        const float lb = dir == 0 ? lb_d0 : lb_d1;
        {
          float loc[16], kin[16]; float run = 0.f;
#pragma unroll
          for (int j = 0; j < 16; ++j) { const float z = fminf(fmaxf(zin[j], -80.f), 80.f);
              const float sg = __builtin_amdgcn_rcpf(1.0f + __expf(-z)); const float f = lb + (1.0f - lb) * sg;
              run += __log2f(f); loc[j] = run; kin[j] = (1.0f - lb) * (1.0f - sg); }
          segs[seg * 128 + d] = run;
          LDS_BARRIER(); H3SEG(4);
          float st[4];
#pragma unroll
          for (int q = 0; q < 4; ++q) st[q] = segs[q * 128 + d];
          float off = 0.f;
#pragma unroll
          for (int q = 0; q < 4; ++q) if (q < seg) off += st[q];
          erho[seg * 128 + d] = __builtin_amdgcn_exp2f(off);
#pragma unroll
          for (int j = 0; j < 16; ++j) QT[(seg * 16 + j) * 136 + d] = (bf16)f2bf(bflo(qin[j]) * __builtin_amdgcn_exp2f(loc[j]));
          float delta = 0.f;
#pragma unroll
          for (int I = 0; I < 4; ++I) { if (I >= seg) { LAS bf16* kp = KT + ((I * (I + 1) / 2 + seg) * 16) * 136 + d;
#pragma unroll
                  for (int j = 0; j < 16; ++j) kp[j * 136] = (bf16)f2bf(kin[j] * __builtin_amdgcn_exp2f(fminf(delta - loc[j], 80.f)));
                  delta += st[I]; } }
          v4u vp[2];
#pragma unroll
          for (int j = 0; j < 16; j += 2) vp[j >> 3][(j >> 1) & 3] = (vin[j] & 0xffffu) | (vin[j + 1] << 16);
          *(LAS v4u*)(vT + d * 72 + seg * 16) = vp[0]; *(LAS v4u*)(vT + d * 72 + seg * 16 + 8) = vp[1]; }
        const bf16* Sst = (const bf16*)(F.ws + WS_HS) + ((size_t)sc * NCHUNK + c) * 16384;
        bf16x8 sfr[4][4];
#pragma unroll
        for (int q4 = 0; q4 < 4; ++q4)
#pragma unroll
            for (int ks = 0; ks < 4; ++ks) sfr[q4][ks] = *(const bf16x8*)((const char*)Sst + (unsigned)((((F.wave >> 2) * 64 + fr) * 128 + fq * 8) * 2) + (unsigned)(q4 * 4096 + ks * 64));
        if (dir == 0) { const int c1 = oc < 4 ? 3 - oc : 135 - oc; int base1, sgn1; hg_rows(b, 1, c1, base1, sgn1);
            hg_load<true>((const float*)(F.ws + WS_GF) + (size_t)MROWS * 512, GQ, GI, base1, sgn1, h, d, seg, zin, vin, qin); }
        else {
#pragma unroll
            for (int tt = 0; tt < 8; ++tt) { const unsigned go = (unsigned)(((base0 + F.wave * 8 + tt) * 512 + h * 128 + (t_l & 63)) * 2);
                gin0[tt] = *(const bf16*)((const char*)GG + go); gin1[tt] = *(const bf16*)((const char*)GG + go + 128); } }
        for (int i = F.tid; i < 64 * 72 / 2; i += 512) ((LAS unsigned*)scS)[i] = 0u;
        LDS_BARRIER(); H3SEG(0);
        for (int blk = F.wave; blk < 10; blk += 8) {
            const int I = blk < 1 ? 0 : (blk < 3 ? 1 : (blk < 6 ? 2 : 3)); const int J = blk - (I * (I + 1)) / 2;
            f32x4v acc = {0.f, 0.f, 0.f, 0.f};
#pragma unroll
            for (int ks = 0; ks < 4; ++ks) { const int dk0 = 32 * ks + 8 * fq;
                const bf16x8 af = *(const LAS bf16x8*)(QT + (16 * I + fr) * 136 + dk0), bfr = *(const LAS bf16x8*)(KT + (blk * 16 + fr) * 136 + dk0);
                acc = __builtin_amdgcn_mfma_f32_16x16x32_bf16(af, bfr, acc, 0, 0, 0); }
#pragma unroll
            for (int r = 0; r < 4; ++r) { const int ii = 16 * I + 4 * fq + r, jj = 16 * J + fr; const float v = (jj <= ii) ? acc[r] : 0.f; scS[ii * 72 + jj] = (bf16)f2bf(v); }
        }
        LDS_BARRIER(); H3SEG(1);
        { const int mt = F.wave & 3, ti = 16 * mt + fr;
          bf16x8 sa[2], qa[4];
#pragma unroll
          for (int ks = 0; ks < 2; ++ks) sa[ks] = *(const LAS bf16x8*)(scS + ti * 72 + ks * 32 + fq * 8);
#pragma unroll
          for (int ks = 0; ks < 4; ++ks) { const int dk0 = 32 * ks + 8 * fq; const bf16x8 qv = *(const LAS bf16x8*)(QT + ti * 136 + dk0);
              const f32x4 e0 = *(const LAS f32x4*)(erho + mt * 128 + dk0), e1 = *(const LAS f32x4*)(erho + mt * 128 + dk0 + 4);
#pragma unroll
              for (int jj = 0; jj < 8; jj += 2) { const float x0 = bf2f((unsigned short)qv[jj]) * (jj < 4 ? e0[jj & 3] : e1[jj & 3]), x1 = bf2f((unsigned short)qv[jj + 1]) * (jj < 4 ? e0[(jj & 3) + 1] : e1[(jj & 3) + 1]);
                  const unsigned pq = pg8::cvt_pk_bf16(x0, x1);
                  qa[ks][jj] = (short)(pq & 0xffffu); qa[ks][jj + 1] = (short)(pq >> 16); } }
#pragma unroll
          for (int q4 = 0; q4 < 4; ++q4) { const int nt = (F.wave >> 2) * 4 + q4; f32x4v acc = {0.f, 0.f, 0.f, 0.f};
#pragma unroll
              for (int ks = 0; ks < 2; ++ks) { const bf16x8 vf = *(const LAS bf16x8*)(vT + (nt * 16 + fr) * 72 + ks * 32 + fq * 8);
                  acc = __builtin_amdgcn_mfma_f32_16x16x32_bf16(sa[ks], vf, acc, 0, 0, 0); }
#pragma unroll
              for (int ks = 0; ks < 4; ++ks) acc = __builtin_amdgcn_mfma_f32_16x16x32_bf16(qa[ks], sfr[q4][ks], acc, 0, 0, 0);
#pragma unroll
              for (int r = 0; r < 4; ++r) { const int is = 16 * mt + 4 * fq + r; const int ot = dir == 0 ? is : 63 - is; LAS float* op = OS + ot * 128 + nt * 16 + fr;
                  if (dir == 0) *op = acc[r]; else *op += acc[r]; } } }
        LDS_BARRIER(); H3SEG(2);
    }
    { const int ln = t_l & 63;
      const float nw0 = F.hgrn_norm_w[l * 128 + ln], nw1 = F.hgrn_norm_w[l * 128 + 64 + ln];
      bf16* MIX = (bf16*)(F.ws + WS_MIX);
      float v0[8], v1[8], ss[8];
#pragma unroll
      for (int tt = 0; tt < 8; ++tt) { const int t = F.wave * 8 + tt; v0[tt] = OS[t * 128 + ln]; v1[tt] = OS[t * 128 + 64 + ln]; ss[tt] = v0[tt] * v0[tt] + v1[tt] * v1[tt]; }
#pragma unroll
      for (int o = 1; o < 64; o <<= 1)
#pragma unroll
          for (int tt = 0; tt < 8; ++tt) ss[tt] += __shfl_xor(ss[tt], o);
#pragma unroll
      for (int tt = 0; tt < 8; ++tt) { const int t = F.wave * 8 + tt; const float rs = 1.0f / sqrtf(ss[tt] * (1.0f / 128.0f) + LN_EPS);
          const size_t row = (size_t)(base0 + t); const float g0 = bflo(gin0[tt]), g1 = bflo(gin1[tt]);
          bf16* mp = MIX + row * DM + ATT_W + CONV_W + h * 128;
          mp[ln] = (bf16)f2bf(v0[tt] * rs * nw0 * (g0 * __builtin_amdgcn_rcpf(1.0f + __expf(-g0)))); mp[64 + ln] = (bf16)f2bf(v1[tt] * rs * nw1 * (g1 * __builtin_amdgcn_rcpf(1.0f + __expf(-g1)))); } }
    LDS_BARRIER(); H3SEG(3);
}
__device__ __forceinline__ void router_finish(Frame& F, float mine, int row, bool doit) {
    float mx = mine;
    mx = fmaxf(mx, __shfl_xor(mx, 1)); mx = fmaxf(mx, __shfl_xor(mx, 2)); mx = fmaxf(mx, __shfl_xor(mx, 4)); mx = fmaxf(mx, __shfl_xor(mx, 8));
    const float ex = expf(mine - mx);
    float den = ex;
    den += __shfl_xor(den, 1); den += __shfl_xor(den, 2); den += __shfl_xor(den, 4); den += __shfl_xor(den, 8);
    const float affv = ex / den;
    float* AFF = (float*)(F.ws + WS_AFF); float* AFFC = (float*)(F.ws + WS_AFFC);
    if (F.lane < 16 && doit) { if (row < NLAT) AFF[((size_t)(row >> 13) * NEXP + F.lane) * SEQ + (row & (SEQ - 1))] = affv;
                       else { const int rc = row - NLAT; AFFC[((size_t)(rc >> 8) * NEXP + F.lane) * CTXL + (rc & (CTXL - 1))] = affv; } }
}
__device__ __forceinline__ void ln1_router(Frame& F, int l, int nrows) {
    LAS float* RW = (LAS float*)(F.lds + 0);
    { const float* rwt = (const float*)(F.ws + WS_RWT) + (size_t)l * DM * NEXP; f32x4 wv[16];
#pragma unroll
      for (int k = 0; k < 16; ++k) wv[k] = *(const f32x4*)(rwt + 4 * (F.tid + 512 * k));
#pragma unroll
      for (int k = 0; k < 16; ++k) *(LAS f32x4*)(RW + 4 * (F.tid + 512 * k)) = wv[k]; }
    __syncthreads();
    const int gw = F.vcu * NWAVES + F.wave, NGW = F.G * NWAVES;
    const float* MOD = (const float*)(F.ws + WS_MOD) + (size_t)l * 3 * 12288;
    bf16* XM = (bf16*)(F.ws + WS_XM);
    const float* lw = F.ln_w + (size_t)(l * 2 + 0) * DM; const float* lbp = F.ln_b + (size_t)(l * 2 + 0) * DM;
    LAS float* PBS = (LAS float*)(F.lds + SPARE_OFF); LAS float* PWS = PBS + DM;
    int staged = -1;
    f32x4 nv[2][8];
#define LN1_FETCH(r0_) do { const int ra_ = (r0_), rb_ = (ra_ + NGW < nrows) ? ra_ + NGW : ra_; \
        const float* za_ = (const float*)(F.ws + WS_Z) + (size_t)ra_ * DM; const float* zb_ = (const float*)(F.ws + WS_Z) + (size_t)rb_ * DM; \
        _Pragma("unroll") for (int j = 0; j < 8; ++j) { nv[0][j] = *(const f32x4*)(za_ + 256 * j + 4 * F.lane); nv[1][j] = *(const f32x4*)(zb_ + 256 * j + 4 * F.lane); } } while (0)
    const int ntrip = (nrows + 2 * NGW - 1) / (2 * NGW);
    if (gw < nrows) LN1_FETCH(gw);
    for (int t = 0; t < ntrip; ++t) {
        const int band_row = 2 * t * NGW; const int band = band_row < NLAT ? (band_row >> 13) : 2;
        if (band != staged) {
            LDS_BARRIER();
            const float* sh2 = MOD + (size_t)band * 12288 + 3 * DM; const float* sc2 = sh2 + DM;
            for (int i = F.tid; i < DM / 4; i += 512) { const f32x4 s1 = *(const f32x4*)(sc2 + 4 * i) + 1.0f;
                *(LAS f32x4*)(PWS + 4 * i) = *(const f32x4*)(lw + 4 * i) * s1; *(LAS f32x4*)(PBS + 4 * i) = *(const f32x4*)(lbp + 4 * i) * s1 + *(const f32x4*)(sh2 + 4 * i); }
            asm volatile("s_waitcnt vmcnt(0)" ::: "memory"); LDS_BARRIER(); staged = band; }
        const int row0 = gw + 2 * t * NGW;
        if (row0 < nrows) {
        const bool has1 = row0 + NGW < nrows; const int rows[2] = {row0, has1 ? row0 + NGW : row0};
        f32x4 v[2][8];
#pragma unroll
        for (int q = 0; q < 2; ++q)
#pragma unroll
            for (int j = 0; j < 8; ++j) v[q][j] = nv[q][j];
        if (row0 + 2 * NGW < nrows) LN1_FETCH(row0 + 2 * NGW);
#pragma unroll
        for (int q = 0; q < 2; ++q) { const int row = rows[q];
            ln_norm_only(v[q]);
#pragma unroll
            for (int j = 0; j < 8; ++j) { const int cc = 256 * j + 4 * F.lane; v[q][j] = v[q][j] * *(const LAS f32x4*)(PWS + cc) + *(const LAS f32x4*)(PBS + cc); }
            if (q == 0 || has1) { bf16* xo = XM + (size_t)row * DM;
#pragma unroll
                for (int j = 0; j < 8; ++j) { v2u w; w.x = pk2(v[q][j][0], v[q][j][1]); w.y = pk2(v[q][j][2], v[q][j][3]); *(v2u*)(xo + 256 * j + 4 * F.lane) = w; } }
            asm volatile("" ::: "memory"); }
        float mine0 = 0.f, mine1 = 0.f;
#pragma unroll 1
        for (int g = 0; g < 4; ++g) {
            float a0[4], a1[4];
#pragma unroll
            for (int k = 0; k < 4; ++k) { float x0 = 0.f, x1 = 0.f; const LAS float* wp = RW + (4 * g + k) * DM + 4 * F.lane;
#pragma unroll
                for (int j = 0; j < 8; ++j) { const f32x4 w4 = *(const LAS f32x4*)(wp + 256 * j);
                    x0 += (v[0][j][0] * w4[0] + v[0][j][1] * w4[1]) + (v[0][j][2] * w4[2] + v[0][j][3] * w4[3]);
                    x1 += (v[1][j][0] * w4[0] + v[1][j][1] * w4[1]) + (v[1][j][2] * w4[2] + v[1][j][3] * w4[3]); }
                a0[k] = x0; a1[k] = x1; }
            const bool u0 = F.lane & 1, u1 = (F.lane >> 1) & 1;
            float b00 = (u0 ? a0[1] : a0[0]) + __shfl_xor(u0 ? a0[0] : a0[1], 1), b01 = (u0 ? a0[3] : a0[2]) + __shfl_xor(u0 ? a0[2] : a0[3], 1);
            float b10 = (u0 ? a1[1] : a1[0]) + __shfl_xor(u0 ? a1[0] : a1[1], 1), b11 = (u0 ? a1[3] : a1[2]) + __shfl_xor(u0 ? a1[2] : a1[3], 1);
            float c0 = (u1 ? b01 : b00) + __shfl_xor(u1 ? b00 : b01, 2), c1 = (u1 ? b11 : b10) + __shfl_xor(u1 ? b10 : b11, 2);
#pragma unroll
            for (int o = 4; o < 64; o <<= 1) { c0 += __shfl_xor(c0, o); c1 += __shfl_xor(c1, o); }
            const bool sel = ((F.lane >> 2) & 3) == g; mine0 = sel ? c0 : mine0; mine1 = sel ? c1 : mine1;
        }
        router_finish(F, mine0, rows[0], true); router_finish(F, mine1, rows[1], has1);
        }
    }
#undef LN1_FETCH
    __syncthreads();
}
__device__ __forceinline__ void topk_unit(Frame& F, int unit) {
    const bool isc = unit >= 32; const int be = isc ? unit - 32 : unit, b = be >> 4, e = be & 15;
    const int N = isc ? CTXL : SEQ, cap = isc ? CAPC : CAP;
    const float* aff = isc ? (const float*)(F.ws + WS_AFFC) + (size_t)be * CTXL : (const float*)(F.ws + WS_AFF) + (size_t)be * SEQ;
    int* IDX = isc ? (int*)(F.ws + WS_IDXC) + be * CAPC : (int*)(F.ws + WS_IDX) + be * CAP;
    float* GATE = isc ? (float*)(F.ws + WS_GATEC) + be * CAPC : (float*)(F.ws + WS_GATE) + be * CAP;
    int* INV = (int*)(F.ws + WS_INV) + (size_t)(isc ? NLAT + b * CTXL : b * SEQ) * 16 + e;
    int* ROWSRC = (int*)(F.ws + WS_ROWSRC) + (isc ? XG_LAT_ROWS + e * 256 + b * 32 : e * 2048 + b * 1024); const int rsrc0 = isc ? NLAT + b * CTXL : b * SEQ;
    LAS unsigned* hist = (LAS unsigned*)(F.lds + 0);
    LAS unsigned* ctl = (LAS unsigned*)(F.lds + 1024);
    LAS unsigned* wtot = (LAS unsigned*)(F.lds + 2048);
    unsigned key[16];
#pragma unroll
    for (int j = 0; j < 16; ++j) { const int n = F.tid * 16 + j; key[j] = n < N ? __float_as_uint(aff[n < N ? n : 0]) : 0u; }
    if (F.tid == 0) { ctl[0] = 0u; ctl[1] = (unsigned)cap; }
    for (int pass = 0; pass < 4; ++pass) {
        const int shift = 24 - 8 * pass;
        if (F.tid < 256) hist[F.tid] = 0u;
        __syncthreads();
        const unsigned prefix = ctl[0]; const unsigned himask = pass == 0 ? 0u : (0xffffffffu << (shift + 8));
#pragma unroll
        for (int j = 0; j < 16; ++j) { const int n = F.tid * 16 + j; if (n < N && (key[j] & himask) == prefix) atomicAdd((unsigned*)&hist[(key[j] >> shift) & 255u], 1u); }
        __syncthreads();
        if (F.wave == 0) {
            const unsigned need = ctl[1];
            const unsigned h0 = hist[4 * F.lane], h1 = hist[4 * F.lane + 1], h2 = hist[4 * F.lane + 2], h3 = hist[4 * F.lane + 3];
            const unsigned mysum = h0 + h1 + h2 + h3;
            unsigned suf = mysum;
#pragma unroll
            for (int o = 1; o < 64; o <<= 1) { const unsigned t = __shfl_down(suf, o); if (F.lane + o < 64) suf += t; }
            const unsigned above = suf - mysum;
            if (above < need && need <= suf) { unsigned cum = above; int bin;
                if (cum + h3 >= need) bin = 3; else { cum += h3; if (cum + h2 >= need) bin = 2; else { cum += h2; if (cum + h1 >= need) bin = 1; else { cum += h1; bin = 0; } } }
                ctl[0] = prefix | ((unsigned)(4 * F.lane + bin) << shift); ctl[1] = need - cum; }
        }
        __syncthreads();
    }
    const unsigned T = ctl[0], need = ctl[1];
    unsigned cnt = 0u;
#pragma unroll
    for (int j = 0; j < 16; ++j) { const int n = F.tid * 16 + j; if (n < N) cnt += (key[j] > T ? 0x10000u : 0u) + (key[j] == T ? 1u : 0u); }
    unsigned inc = cnt;
#pragma unroll
    for (int o = 1; o < 64; o <<= 1) { const unsigned t = __shfl_up(inc, o); if (F.lane >= o) inc += t; }
    if (F.lane == 63) wtot[F.wave] = inc;
    __syncthreads();
    unsigned woff = 0u, total = 0u;
#pragma unroll
    for (int w = 0; w < 8; ++w) { const unsigned t = wtot[w]; if (w < F.wave) woff += t; total += t; }
    unsigned excl = woff + inc - cnt;
    const unsigned ngt = total >> 16;
    unsigned g_before = excl >> 16, e_before = excl & 0xffffu;
#pragma unroll
    for (int j = 0; j < 16; ++j) { const int n = F.tid * 16 + j; if (n < N) {
        int slot = -1;
        if (key[j] > T) { slot = (int)g_before; ++g_before; }
        else if (key[j] == T) { if (e_before < need) slot = (int)(ngt + e_before); ++e_before; }
        INV[(size_t)n * 16] = slot;
        if (slot >= 0) { IDX[slot] = n; GATE[slot] = __uint_as_float(key[j]); ROWSRC[slot] = rsrc0 + n; } } }
    if (isc && b == 0 && F.tid < 192) ((int*)(F.ws + WS_ROWSRC))[XG_LAT_ROWS + e * 256 + 64 + F.tid] = NLAT;
    __syncthreads();
}
__device__ __forceinline__ void gather_rows(Frame& F, int l) {
    const int gw = F.vcu * NWAVES + F.wave, NGW = F.G * NWAVES;
    const bf16* XM = (const bf16*)(F.ws + WS_XM); bf16* XG = (bf16*)(F.ws + WS_XG);
    const int* IDX = (const int*)(F.ws + WS_IDX); const int* IDXC = (const int*)(F.ws + WS_IDXC);
    const int ntot = XG_LAT_ROWS + (l == 0 ? NEXP * 64 : 0);
    for (int r = gw; r < ntot; r += NGW) {
        size_t src, dst;
        if (r < XG_LAT_ROWS) { const int e = r >> 11, b = (r >> 10) & 1, slot = r & 1023; src = (size_t)(b * SEQ + IDX[(b * NEXP + e) * CAP + slot]); dst = (size_t)r; }
        else { const int rc = r - XG_LAT_ROWS, e = rc >> 6, b = (rc >> 5) & 1, slot = rc & 31; src = (size_t)(NLAT + b * CTXL + IDXC[(b * NEXP + e) * CAPC + slot]); dst = (size_t)(XG_LAT_ROWS + e * 256 + b * 32 + slot); }
        const v4u* sp = (const v4u*)(XM + src * DM) + F.lane; v4u* dp = (v4u*)(XG + dst * DM) + F.lane;
        v4u t0 = sp[0], t1 = sp[64], t2 = sp[128], t3 = sp[192];
        dp[0] = t0; dp[64] = t1; dp[128] = t2; dp[192] = t3;
    }
}
__device__ __forceinline__ void combine_ln2(Frame& F, int l, int nrows) {
    const int gw = F.vcu * NWAVES + F.wave, NGW = F.G * NWAVES;
    const float* MODL = (const float*)(F.ws + WS_MOD) + (size_t)l * 3 * 12288;
    const float* R1 = (const float*)(F.ws + WS_Z); const bf16* Y = (const bf16*)(F.ws + WS_Y);
    const int* INV = (const int*)(F.ws + WS_INV);
    const float* GATE = (const float*)(F.ws + WS_GATE); const float* GATEC = (const float*)(F.ws + WS_GATEC);
    LAS float* PG2 = (LAS float*)(F.lds + 0); LAS float* PLW = PG2 + 3 * DM; LAS float* PLB = PLW + DM; LAS float* PSH = PLB + DM; LAS float* PSC = PSH + 3 * DM;
    LAS float* PLW1 = PSC + 3 * DM; LAS float* PLB1 = PLW1 + DM;
    { const float* lw = F.ln_w + (size_t)(l * 2 + 1) * DM; const float* lbp = F.ln_b + (size_t)(l * 2 + 1) * DM;
      const float* MN = (const float*)(F.ws + WS_MOD) + (size_t)((l + 1 < DEPTH) ? l + 1 : l) * 3 * 12288;
      for (int i = F.tid; i < DM / 4; i += 512) { const int c = 4 * i;
          *(LAS f32x4*)(PLW + c) = *(const f32x4*)(lw + c); *(LAS f32x4*)(PLB + c) = *(const f32x4*)(lbp + c);
          *(LAS f32x4*)(PLW1 + c) = *(const f32x4*)(F.ln_w + (size_t)(l * 2 + 0) * DM + c); *(LAS f32x4*)(PLB1 + c) = *(const f32x4*)(F.ln_b + (size_t)(l * 2 + 0) * DM + c);
#pragma unroll
          for (int r = 0; r < 3; ++r) { *(LAS f32x4*)(PG2 + r * DM + c) = *(const f32x4*)(MODL + (size_t)r * 12288 + 5 * DM + c);
              *(LAS f32x4*)(PSH + r * DM + c) = *(const f32x4*)(MN + (size_t)r * 12288 + c); *(LAS f32x4*)(PSC + r * DM + c) = *(const f32x4*)(MN + (size_t)r * 12288 + DM + c) + 1.0f; } }
      __syncthreads(); }
    const int le = F.lane & 15;
    int nslot = -1, n2slot = -1; float ngate = 0.f; f32x4 nx[8];
#define CB_SLOT(r_) (INV[(size_t)(r_) * 16 + le])
#define CB_GATE(r_, sl_) ((sl_) >= 0 ? (((r_) < NLAT) ? GATE[((((r_) >> 13)) * NEXP + le) * CAP + (sl_)] : GATEC[(((((r_) - NLAT) >> 8)) * NEXP + le) * CAPC + (sl_)]) : 0.f)
#define CB_ROW(r_) do { const float* xr__ = R1 + (size_t)(r_) * DM; _Pragma("unroll") for (int j = 0; j < 8; ++j) nx[j] = *(const f32x4*)(xr__ + 256 * j + 4 * F.lane); } while (0)
    if (gw < nrows) { nslot = CB_SLOT(gw); if (gw + NGW < nrows) n2slot = CB_SLOT(gw + NGW); ngate = CB_GATE(gw, nslot); CB_ROW(gw); }
    for (int row = gw; row < nrows; row += NGW) {
        const bool lat = row < NLAT; const int brow = lat ? (row >> 13) : 2; const int b = lat ? (row >> 13) : ((row - NLAT) >> 8);
        f32x4 moe[8];
#pragma unroll
        for (int j = 0; j < 8; ++j) moe[j] = (f32x4){0.f, 0.f, 0.f, 0.f};
        const int myslot = nslot; const float mygate = ngate; f32x4 xcur[8];
#pragma unroll
        for (int j = 0; j < 8; ++j) xcur[j] = nx[j];
        if (row + NGW < nrows) { const int rn = row + NGW; nslot = n2slot;
            ngate = CB_GATE(rn, nslot); if (rn + NGW < nrows) n2slot = CB_SLOT(rn + NGW); CB_ROW(rn); }
        unsigned long long mask = __ballot(myslot >= 0 && F.lane < 16);
        while (mask) {
            const int e0 = __builtin_ctzll(mask); mask &= mask - 1;
            const bool two = mask != 0; const int e1 = two ? __builtin_ctzll(mask) : e0; if (two) mask &= mask - 1;
            const int s0 = __shfl(myslot, e0), s1 = __shfl(myslot, e1);
            const float g0 = __shfl(mygate, e0), g1 = two ? __shfl(mygate, e1) : 0.f;
            const size_t yr0 = lat ? (size_t)(e0 * 2048 + b * 1024 + s0) : (size_t)(XG_LAT_ROWS + e0 * 256 + b * 32 + s0);
            const size_t yr1 = lat ? (size_t)(e1 * 2048 + b * 1024 + s1) : (size_t)(XG_LAT_ROWS + e1 * 256 + b * 32 + s1);
            const bf16* yp0 = Y + yr0 * DM + 4 * F.lane; const bf16* yp1 = Y + yr1 * DM + 4 * F.lane;
            v2u w0[8], w1[8];
#pragma unroll
            for (int j = 0; j < 8; ++j) { w0[j] = *(const v2u*)(yp0 + 256 * j); w1[j] = *(const v2u*)(yp1 + 256 * j); }
#pragma unroll
            for (int j = 0; j < 8; ++j) {
                moe[j][0] += g0 * bflo(w0[j].x); moe[j][1] += g0 * bfhi(w0[j].x); moe[j][2] += g0 * bflo(w0[j].y); moe[j][3] += g0 * bfhi(w0[j].y);
                moe[j][0] += g1 * bflo(w1[j].x); moe[j][1] += g1 * bfhi(w1[j].x); moe[j][2] += g1 * bflo(w1[j].y); moe[j][3] += g1 * bfhi(w1[j].y); }
        }
        const LAS float* g2 = PG2 + brow * DM;
        asm volatile("" ::: "memory");
        ln_norm_only(xcur);
        asm volatile("" ::: "memory");
#pragma unroll
        for (int j = 0; j < 8; ++j) { const int cc = 256 * j + 4 * F.lane;
            xcur[j] = (xcur[j] * *(const LAS f32x4*)(PLW1 + cc) + *(const LAS f32x4*)(PLB1 + cc)) * ALPHA_RES + *(const LAS f32x4*)(g2 + cc) * moe[j]; }
        asm volatile("" ::: "memory");
        ln_inplace_lds(xcur, PLW, PLB, F.lane);
        float* orow = lat ? F.out + (size_t)row * DM : (float*)(F.ws + WS_R2C) + (size_t)(row - NLAT) * DM;
#pragma unroll
        for (int j = 0; j < 8; ++j) *(f32x4*)(orow + 256 * j + 4 * F.lane) = xcur[j];
        if (l + 1 < DEPTH) store_mod_bf16_lds((bf16*)(F.ws + WS_XM) + (size_t)row * DM, xcur, PSH + brow * DM, PSC + brow * DM, F.lane);
    }
#undef CB_SLOT
#undef CB_GATE
#undef CB_ROW
    __syncthreads();
}

#ifndef MK_ONE_LAUNCH
#define MK_ONE_LAUNCH 1
#endif
constexpr int NPHASE = 2 + 11 * DEPTH;
struct Args { const float* in[19]; float* out; unsigned char* ws; int ph_lo, ph_hi; };
__global__ void __launch_bounds__(NWAVES * 64, 2) mk_fwd(Args args) {
    extern __shared__ __attribute__((aligned(16))) unsigned char lds[];
    Frame F;
    F.lds = (LAS unsigned char*)lds; F.ldsg = (char*)lds;
    F.tid = threadIdx.x; F.lane = F.tid & 63; F.wave = __builtin_amdgcn_readfirstlane(F.tid >> 6);
    F.G = gridDim.x; { const int bx = blockIdx.x; F.vcu = (F.G % 8 == 0) ? (bx % 8) * (F.G / 8) + bx / 8 : bx; }
    F.ws = args.ws; F.out = args.out;
    F.x = args.in[0]; F.c = args.in[1]; F.ctx = args.in[2]; F.c_ctx = args.in[3]; F.w_mod = args.in[4]; F.b_mod = args.in[5]; F.w_in = args.in[6]; F.w_conv = args.in[7];
    F.lambda_qk = args.in[8]; F.subln_w = args.in[9]; F.lb_logits = args.in[10]; F.hgrn_norm_w = args.in[11]; F.w_out = args.in[12]; F.ln_w = args.in[13]; F.ln_b = args.in[14];
    F.w_router = args.in[15]; F.w_gate = args.in[16]; F.w_up = args.in[17]; F.w_down = args.in[18];
    volatile LAS unsigned* MISC = (volatile LAS unsigned*)(F.lds + MISC_OFF);
    for (int u = F.tid; u < (LDS_BYTES - RING_BYTES) / 4; u += NWAVES * 64) ((LAS unsigned*)(F.lds + RING_BYTES))[u] = 0u;
    __syncthreads();
    const int lo = args.ph_lo, hi = args.ph_hi;
    const bool one = (hi - lo) > 1;
    XcdBarrier bar; bar.bar = (unsigned*)(F.ws + WS_CTL) + CW_BAR; bar.x = 0; bar.st = nullptr;
    if (one) bar = xcd_barrier_post((unsigned*)(F.ws + WS_CTL) + CW_BAR, MISC + 8);
#ifndef MK_MASK
#define MK_MASK 0xffffffffu
#endif
#define IN(k) (lo <= (k) && (k) < hi)
#define ON(j) ((MK_MASK >> (j)) & 1u)
#ifndef MK_REP
#define MK_REP 0u
#endif
#define NREP(j) (1 + (int)((MK_REP >> (j)) & 1u))
#ifndef MK_BAR2
#define MK_BAR2 0
#endif
#ifndef MK_TSEL
#define MK_TSEL (-1)
#endif
    unsigned long long t_prev = 0ull, t_acc = 0ull;
    if (MK_TSEL >= 0) t_prev = __builtin_amdgcn_s_memrealtime();
#define TSTAMP(j) do { if (MK_TSEL >= 0) { const unsigned long long t_now = __builtin_amdgcn_s_memrealtime(); if (MK_TSEL == (j)) t_acc += t_now - t_prev; t_prev = t_now; } } while (0)
#define SEAM(k) do { if (IN(k) && IN((k) + 1)) { xcd_barrier(bar); if (MK_BAR2) xcd_barrier(bar); } } while (0)
#define RELAUNDER() do { int t_ = threadIdx.x; asm volatile("" : "+v"(t_)); F.tid = t_; F.lane = t_ & 63; F.wave = __builtin_amdgcn_readfirstlane(t_ >> 6); } while (0)

    if (ON(11) && IN(0)) for (int rep_ = 0; rep_ < NREP(11); ++rep_) { RELAUNDER(); p0_prologue(F); } SEAM(0); TSTAMP(11);
    if (ON(12) && IN(1)) for (int rep_ = 0; rep_ < NREP(12); ++rep_) { RELAUNDER(); p1_modulate(F); } SEAM(1); TSTAMP(12);

    for (int l = 0; l < DEPTH; ++l) {
        const int pb = 2 + 11 * l;
        const bool need_ctx = (l + 1 < DEPTH);
        const float* MODL = (const float*)(F.ws + WS_MOD) + (size_t)l * 3 * 12288;
        if (ON(0) && IN(pb + 0)) for (int rep_ = 0; rep_ < NREP(0); ++rep_) { RELAUNDER();
            pg8::Gemm g{(const pg8::bf16_t*)(F.ws + WS_XM), (const pg8::bf16_t*)(F.ws + WS_WIN) + (size_t)l * PROJ_W * DM, MROWS, PROJ_W, DM};
            pg8::StaticOrder S; S.init(MROWS, PROJ_W, F.G, (int)blockIdx.x);
            pg8::EpiProj E{(pg8::bf16_t*)(F.ws + WS_QKV), (pg8::bf16_t*)(F.ws + WS_CG), (float*)(F.ws + WS_GF)};
            pg8::gemm_phase<pg8::EpiProj, pg8::StaticOrder, true, true>(F.lds, g, S, E);
            { const int nu = (MROWS / 256) * (PROJ_W / 256), extra = nu % F.G, bx = (int)blockIdx.x;
              if (extra == 0 || bx >= extra) { RELAUNDER(); deferred_convert(F, l == 0 ? 0 : CV_S4, l == 0 ? CV_S1 : CV_DEFER, extra == 0 ? bx : bx - extra, extra == 0 ? F.G : F.G - extra); } }
        }
        SEAM(pb + 0); TSTAMP(0);
        if (ON(1) && IN(pb + 1)) for (int rep_ = 0; rep_ < NREP(1); ++rep_) { RELAUNDER();
            if (ON(13)) for (int r2_ = 0; r2_ < NREP(13); ++r2_) hg_h1_units(F, l);
            RELAUNDER(); if (ON(14)) for (int r2_ = 0; r2_ < NREP(14); ++r2_) conv_rows(F, l, need_ctx ? MROWS : NLAT);
            RELAUNDER(); if (ON(15)) for (int r2_ = 0; r2_ < NREP(15); ++r2_) {
            const float* lq = F.lambda_qk + (size_t)l * 4 * 64;
            const float s1 = wave_sum(lq[F.lane] * lq[64 + F.lane]), s2 = wave_sum(lq[128 + F.lane] * lq[192 + F.lane]);
            const float li = lambda_init_of(l), lam = expf(s1) - expf(s2) + li, post = 1.0f - li;
            const bf16* Q = (const bf16*)(F.ws + WS_QKV); const bf16* K = Q + (size_t)MROWS * 1024; const bf16* V = K + (size_t)MROWS * 1024;
            bf16* MIX = (bf16*)(F.ws + WS_MIX);
            const int nunits = 1024 + (need_ctx ? 32 : 0);
            __syncthreads();
            for (int i = 0;; ++i) { const int u = i * F.G + F.vcu; if (u >= nunits) break;
                if (u < 1024) { const int bh = u >> 6, qb = u & 63, b = bh >> 3, h = bh & 7; const size_t q0 = (size_t)b * SEQ + qb * 128;
                    att::attn_unit(Q + q0 * 1024 + h * 128, K + h * 128, V + h * 128, b * SEQ, 128, NLAT + b * CTXL, 132, lam, post, F.subln_w + l * 128, MIX + q0 * DM + h * 128, F.ldsg); }
                else { const int uc = u - 1024, bh = uc >> 1, qb = uc & 1, b = bh >> 3, h = bh & 7; const size_t q0 = (size_t)NLAT + b * CTXL + qb * 128;
                    att::attn_unit(Q + q0 * 1024 + h * 128, K + h * 128, V + h * 128, 0, 0, NLAT + b * CTXL, 4, lam, post, F.subln_w + l * 128, MIX + q0 * DM + h * 128, F.ldsg); } }
            }
        }
        SEAM(pb + 1); TSTAMP(1);
        if (ON(2) && IN(pb + 2)) for (int rep_ = 0; rep_ < NREP(2); ++rep_) { RELAUNDER(); hg_h2(F); }
        SEAM(pb + 2); TSTAMP(2);
        if (ON(3) && IN(pb + 3)) for (int rep_ = 0; rep_ < NREP(3); ++rep_) { RELAUNDER();
            unsigned* tick = (unsigned*)(F.ws + WS_CTL) + 8192 + 64 * l; volatile LAS unsigned* tk = (volatile LAS unsigned*)(F.lds + RING_BYTES + 64);
            const int nun = need_ctx ? 8 * NCHUNK : 8 * (NCHUNK - 4);
            for (;;) {
                if (F.tid == 0) *tk = __hip_atomic_fetch_add(tick, 1u, __ATOMIC_RELAXED, __HIP_MEMORY_SCOPE_AGENT);
                __syncthreads();
                const int t = (int)*tk;
                __syncthreads();
                if (t >= nun) break;
                const int u = need_ctx ? t : (t / (NCHUNK - 4)) * NCHUNK + 4 + t % (NCHUNK - 4);
                H3SEG(5);
                hg_h3_unit(F, l, u);
            } }
        SEAM(pb + 3); TSTAMP(3);
        if (ON(4) && IN(pb + 4)) for (int rep_ = 0; rep_ < NREP(4); ++rep_) { RELAUNDER();
            const int M = need_ctx ? MROWS : NLAT;
            pg8::Gemm g{(const pg8::bf16_t*)(F.ws + WS_MIX), (const pg8::bf16_t*)(F.ws + WS_WOUT) + (size_t)l * DM * DM, M, DM, DM};
            pg8::StaticOrder S; S.init(M, DM, F.G, (int)blockIdx.x);
            pg8::EpiOut E{l == 0 ? F.x : (const float*)F.out, l == 0 ? F.ctx : (const float*)(F.ws + WS_R2C), (float*)(F.ws + WS_Z), MODL};
            pg8::gemm_phase<pg8::EpiOut, pg8::StaticOrder, true, true>(F.lds, g, S, E);
            if (l == 0) { const int nu = (M / 256) * (DM / 256), extra = nu % F.G, bx = (int)blockIdx.x;
              if (extra == 0 || bx >= extra) { RELAUNDER(); deferred_convert(F, CV_S1, CV_S2, extra == 0 ? bx : bx - extra, extra == 0 ? F.G : F.G - extra); } }
        }
        SEAM(pb + 4); TSTAMP(4);
        if (ON(5) && IN(pb + 5)) for (int rep_ = 0; rep_ < NREP(5); ++rep_) { RELAUNDER(); ln1_router(F, l, need_ctx ? MROWS : NLAT); }
        SEAM(pb + 5); TSTAMP(5);
        if (ON(6) && IN(pb + 6)) for (int rep_ = 0; rep_ < NREP(6); ++rep_) { RELAUNDER(); for (int u = blockIdx.x; u < (need_ctx ? 64 : 32); u += F.G) topk_unit(F, u); }
        SEAM(pb + 6); TSTAMP(6);
        if (ON(8) && IN(pb + 8)) for (int rep_ = 0; rep_ < NREP(8); ++rep_) { RELAUNDER();
            pg8::Gemm g{(const pg8::bf16_t*)(F.ws + WS_XM), (const pg8::bf16_t*)(F.ws + WS_WGU) + (size_t)l * NEXP * 2048 * DM, XG_ROWS, NEXP * 2048, DM};
            pg8::MoeOrder S{F.G, (int)blockIdx.x, 1024 + (need_ctx ? 128 : 0)};
            pg8::EpiMoe1 E{(pg8::bf16_t*)(F.ws + WS_HID)};
            pg8::gemm_phase<pg8::EpiMoe1, pg8::MoeOrder, true, true, true>(F.lds, g, S, E, (const int*)(F.ws + WS_ROWSRC));
            if (l == 0) { const int extra = S.ntot % F.G, bx = (int)blockIdx.x;
              if (extra == 0 || bx >= extra) { RELAUNDER(); deferred_convert(F, CV_S2, CV_S3, extra == 0 ? bx : bx - extra, extra == 0 ? F.G : F.G - extra); } }
        }
        SEAM(pb + 8); TSTAMP(8);
        if (ON(9) && IN(pb + 9)) for (int rep_ = 0; rep_ < NREP(9); ++rep_) { RELAUNDER();
            pg8::Gemm g{(const pg8::bf16_t*)(F.ws + WS_HID), (const pg8::bf16_t*)(F.ws + WS_WD) + (size_t)l * NEXP * DM * EFF, XG_ROWS, NEXP * 2048, EFF};
            pg8::MoeOrder S{F.G, (int)blockIdx.x, 1024 + (need_ctx ? 128 : 0)};
            pg8::EpiMoe2 E{(pg8::bf16_t*)(F.ws + WS_Y)};
            pg8::gemm_phase<pg8::EpiMoe2, pg8::MoeOrder, true, true>(F.lds, g, S, E);
            if (l == 0) { const int extra = S.ntot % F.G, bx = (int)blockIdx.x;
              if (extra == 0 || bx >= extra) { RELAUNDER(); deferred_convert(F, CV_S3, CV_S4, extra == 0 ? bx : bx - extra, extra == 0 ? F.G : F.G - extra); } }
        }
        SEAM(pb + 9); TSTAMP(9);
        if (ON(10) && IN(pb + 10)) for (int rep_ = 0; rep_ < NREP(10); ++rep_) { RELAUNDER(); combine_ln2(F, l, need_ctx ? MROWS : NLAT); }
        SEAM(pb + 10); TSTAMP(10);
    }
    if (MK_HSEL >= 0 && blockIdx.x == 0) { __syncthreads(); const unsigned hacc = *(volatile LAS unsigned*)(F.lds + RING_BYTES + 128); const unsigned long long t_end = __builtin_amdgcn_s_memrealtime(); while (__builtin_amdgcn_s_memrealtime() - t_end < (unsigned long long)hacc) __builtin_amdgcn_s_sleep(8); }
    if (MK_TSEL >= 0 && blockIdx.x == 0) { __syncthreads(); const unsigned long long t_end = __builtin_amdgcn_s_memrealtime(); while (__builtin_amdgcn_s_memrealtime() - t_end < t_acc) __builtin_amdgcn_s_sleep(8); }
#undef IN
#undef SEAM
}

extern "C" void kernel_launch(void* const* d_in, const int* in_sizes, int n_in, void* d_out, int out_size, void* d_ws, size_t ws_size, hipStream_t stream) {
    static int grid = 0;
    if (grid == 0) {
        if (n_in != 19 || in_sizes[0] != NLAT * DM || out_size != NLAT * DM || ws_size < WS_END) { fprintf(stderr, "kernel_launch: shape mismatch (n_in %d, in0 %d, out %d, ws %zu, need %zu)\n", n_in, n_in > 0 ? in_sizes[0] : -1, out_size, ws_size, (size_t)WS_END); grid = -1; return; }
        int dev = 0, cus = 0, per_cu = 0;
        if (hipGetDevice(&dev) != hipSuccess || hipDeviceGetAttribute(&cus, hipDeviceAttributeMultiprocessorCount, dev) != hipSuccess) { grid = -1; return; }
        if (hipFuncSetAttribute((const void*)mk_fwd, hipFuncAttributeMaxDynamicSharedMemorySize, LDS_BYTES) != hipSuccess) { fprintf(stderr, "kernel_launch: hipFuncSetAttribute failed\n"); grid = -1; return; }
        if (hipOccupancyMaxActiveBlocksPerMultiprocessor(&per_cu, (const void*)mk_fwd, NWAVES * 64, LDS_BYTES) != hipSuccess || per_cu < 1) fprintf(stderr, "kernel_launch: occupancy query reports %d\n", per_cu);
        (void)hipGetLastError();
        grid = cus;
        if (SEQ % (2 * NWAVES * grid) != 0) { fprintf(stderr, "kernel_launch: the LN1 phase stages per-batch vectors per trip of 2 x %d rows, which must divide the %d rows of a batch (grid %d); nothing launched\n", NWAVES * grid, SEQ, grid); grid = -1; return; }
    }
    if (grid < 0) return;
    (void)hipMemsetAsync((char*)d_ws + WS_CTL, 0, CTL_ZERO_BYTES, stream);
    Args a{};
    for (int i = 0; i < 19; ++i) a.in[i] = (const float*)d_in[i];
    a.out = (float*)d_out; a.ws = (unsigned char*)d_ws;
#if MK_ONE_LAUNCH
    a.ph_lo = 0; a.ph_hi = NPHASE;
    hipLaunchKernelGGL(mk_fwd, dim3(grid), dim3(NWAVES * 64), LDS_BYTES, stream, a);
#else
    for (int p = 0; p < NPHASE; ++p) { a.ph_lo = p; a.ph_hi = p + 1; hipLaunchKernelGGL(mk_fwd, dim3(grid), dim3(NWAVES * 64), LDS_BYTES, stream, a); }
#endif
}
```

```cpp
#define MK_REP 0u
#include <hip/hip_runtime.h>
#include <cstdio>
#include <cstdint>

constexpr int DM = 2048, NBATCH = 2, SEQ = 8192, CTXL = 256, DEPTH = 2;
constexpr int NLAT = NBATCH * SEQ;
constexpr int NCTX = NBATCH * CTXL;
constexpr int MROWS = NLAT + NCTX;
constexpr int PROJ_W = 7168, ATT_W = 1024, CONV_W = 512, HG_W = 512;
constexpr int NEXP = 16, EFF = 1024, CAP = 1024, CAPC = 32;
constexpr int NCHUNK = 132;
constexpr int NSCAN = 16;
constexpr float ALPHA_RES = 1.4142135623730951f;
constexpr float LN_EPS = 1e-6f;
constexpr int XG_LAT_ROWS = NEXP * 2048;
constexpr int XG_ROWS = XG_LAT_ROWS + NEXP * 256;

namespace pg8 {
#define PG8_LAS __attribute__((address_space(3)))
typedef unsigned short bf16_t;
typedef short bf16x8 __attribute__((ext_vector_type(8)));
typedef float f32x4 __attribute__((ext_vector_type(4)));
typedef unsigned u32x4 __attribute__((ext_vector_type(4)));
constexpr int BM = 256, BK = 64, HALF = 128, HTB = HALF * BK * 2  , STAGE_BYTES = 8 * HTB, NXCD = 8, WGM = 8;

__host__ __device__ __forceinline__ int lds_byte(int r, int c) { const int st = (r >> 4) * 2 + (c >> 5), rr = r & 15, cc = c & 31, ob = rr * 64 + cc * 2; return st * 1024 + (ob ^ (((ob >> 9) & 1) << 5)); }
__host__ __device__ __forceinline__ void stage_rc(int b, int& R, int& C) { const int st = b / 1024, sb = b % 1024, swz = sb ^ (((sb >> 9) & 1) << 5); R = (st >> 1) * 16 + swz / 64; C = (st & 1) * 32 + (swz % 64) / 2; }
__host__ __device__ __forceinline__ int perm32(int rho) { const int n = rho >> 4, i = rho & 15; return 8 * (i >> 2) + 4 * n + (i & 3); }

struct Unit { int pm, pn; };
struct Gemm { const bf16_t* A; const bf16_t* Bt; int M, N, K; };

struct StaticOrder {
    int nM, nN, nwg, G, c;
    __host__ __device__ void init(int M, int N, int G_, int c_) { nM = M / BM; nN = N / BM; nwg = nM * nN; G = G_; c = c_; }
    __host__ __device__ bool next(int i, Unit& u) const {
        const long L = (long)i * G + c; if (L >= nwg) return false;
        int wgid = (int)L; { const int q = nwg / NXCD, r = nwg % NXCD, xcd = wgid % NXCD, off = wgid / NXCD; wgid = (xcd < r ? xcd * (q + 1) : r * (q + 1) + (xcd - r) * q) + off; }
        const int nig = WGM * nN, gid = wgid / nig, fm = gid * WGM, gsz = (nM - fm) < WGM ? (nM - fm) : WGM;
        u.pm = fm + ((wgid % nig) % gsz); u.pn = (wgid % nig) / gsz; return true;
    }
    __device__ __forceinline__ void a_ready(const Unit&) const {}
    __device__ __forceinline__ void done(const Unit&) const {}
};

__device__ __forceinline__ unsigned cvt_pk_bf16(float lo, float hi) { unsigned r; asm volatile("v_cvt_pk_bf16_f32 %0, %1, %2" : "=v"(r) : "v"(lo), "v"(hi)); return r; }

typedef unsigned u32x2 __attribute__((ext_vector_type(2)));
struct EpiProj {
    static constexpr bool PERM = false, AFTER_DRAIN = false;
    bf16_t* QKV;
    bf16_t* CG;
    float*  GF;
    __device__ __forceinline__ void operator()(const f32x4 (&acc)[2][2][4][2], const Unit& u, int wr, int wc, int fr, int fq) const {
        const int pn = u.pn;
        const int row0 = u.pm * BM + wr * 64 + fr;
        if (pn >= 24) {
            float* base = GF + (size_t)((pn - 24) >> 1) * ((size_t)MROWS * 512) + ((pn - 24) & 1) * 256 + wc * 32 + 4 * fq;
#pragma unroll
            for (int ai = 0; ai < 2; ++ai)
#pragma unroll
                for (int m = 0; m < 4; ++m) { float* rowp = base + (size_t)(row0 + ai * HALF + m * 16) * 512;
#pragma unroll
                    for (int bj = 0; bj < 2; ++bj)
#pragma unroll
                        for (int n = 0; n < 2; ++n) *(f32x4*)(rowp + bj * HALF + n * 16) = acc[ai][bj][m][n]; }
            return;
        }
        bf16_t* base; int ld; bool rope = false;
        if (pn < 12) { base = QKV + (size_t)(pn >> 2) * ((size_t)MROWS * 1024) + (pn & 3) * 256; ld = 1024; rope = (pn < 8) && (u.pm < 64); }
        else { base = CG + (size_t)((pn - 12) >> 1) * ((size_t)MROWS * 512) + ((pn - 12) & 1) * 256; ld = 512; }
        base += wc * 32 + 4 * fq;
        if (rope) {
            f32x4 inv;
#pragma unroll
            for (int j = 0; j < 4; ++j) inv[j] = exp2f(-(float)(4 * fq + j) * (13.287712379549449f / 16.0f));
#pragma unroll
            for (int ai = 0; ai < 2; ++ai)
#pragma unroll
                for (int m = 0; m < 4; ++m) { const int row = row0 + ai * HALF + m * 16; const int t = row & (SEQ - 1);
                    const float pos = (float)((wc & 1) ? (t & 63) : (t >> 6));
                    f32x4 cs, sn;
#pragma unroll
                    for (int j = 0; j < 4; ++j) { const float ang = pos * inv[j]; cs[j] = __cosf(ang); sn[j] = __sinf(ang); }
                    bf16_t* rowp = base + (size_t)row * ld;
#pragma unroll
                    for (int bj = 0; bj < 2; ++bj) { const f32x4 x1 = acc[ai][bj][m][0], x2 = acc[ai][bj][m][1];
                        const f32x4 o1 = x1 * cs - x2 * sn, o2 = x2 * cs + x1 * sn;
                        u32x2 w1, w2; w1.x = cvt_pk_bf16(o1[0], o1[1]); w1.y = cvt_pk_bf16(o1[2], o1[3]); w2.x = cvt_pk_bf16(o2[0], o2[1]); w2.y = cvt_pk_bf16(o2[2], o2[3]);
                        *(u32x2*)(rowp + bj * HALF) = w1; *(u32x2*)(rowp + bj * HALF + 16) = w2; } }
        } else {
#pragma unroll
            for (int ai = 0; ai < 2; ++ai)
#pragma unroll
                for (int m = 0; m < 4; ++m) { bf16_t* rowp = base + (size_t)(row0 + ai * HALF + m * 16) * ld;
#pragma unroll
                    for (int bj = 0; bj < 2; ++bj)
#pragma unroll
                        for (int n = 0; n < 2; ++n) { const f32x4 v = acc[ai][bj][m][n]; u32x2 w; w.x = cvt_pk_bf16(v[0], v[1]); w.y = cvt_pk_bf16(v[2], v[3]);
                            *(u32x2*)(rowp + bj * HALF + n * 16) = w; } }
        }
    }
};
struct EpiOut {
    static constexpr bool PERM = false, AFTER_DRAIN = false;
    const float* xin_lat; const float* xin_ctx; float* Z; const float* modl;
    __device__ __forceinline__ void operator()(const f32x4 (&acc)[2][2][4][2], const Unit& u, int wr, int wc, int fr, int fq) const {
        const int brow = u.pm < 32 ? 0 : (u.pm < 64 ? 1 : 2);
        const int row0 = u.pm * BM + wr * 64 + fr, col0 = u.pn * BM + wc * 32 + 4 * fq;
        const float* g1 = modl + (size_t)brow * 12288 + 4096 + col0;
        const float* xin = (u.pm < 64) ? xin_lat : (xin_ctx - (size_t)NLAT * DM);
        f32x4 gv[2][2];
#pragma unroll
        for (int bj = 0; bj < 2; ++bj)
#pragma unroll
            for (int n = 0; n < 2; ++n) gv[bj][n] = *(const f32x4*)(g1 + bj * HALF + n * 16);
#pragma unroll
        for (int ai = 0; ai < 2; ++ai)
#pragma unroll
            for (int m2 = 0; m2 < 4; m2 += 2) { f32x4 xv[2][2][2];
#pragma unroll
                for (int mm = 0; mm < 2; ++mm) { const size_t off = (size_t)(row0 + ai * HALF + (m2 + mm) * 16) * DM + col0;
#pragma unroll
                    for (int bj = 0; bj < 2; ++bj)
#pragma unroll
                        for (int n = 0; n < 2; ++n) xv[mm][bj][n] = *(const f32x4*)(xin + off + bj * HALF + n * 16); }
#pragma unroll
                for (int mm = 0; mm < 2; ++mm) { const size_t off = (size_t)(row0 + ai * HALF + (m2 + mm) * 16) * DM + col0;
#pragma unroll
                    for (int bj = 0; bj < 2; ++bj)
#pragma unroll
                        for (int n = 0; n < 2; ++n) *(f32x4*)(Z + off + bj * HALF + n * 16) = xv[mm][bj][n] * ALPHA_RES + gv[bj][n] * acc[ai][bj][m2 + mm][n]; }
                asm volatile("" ::: "memory"); }
    }
};
__device__ __forceinline__ float silu_f(float a) { return a * __builtin_amdgcn_rcpf(1.0f + __expf(-a)); }
struct EpiMoe1 {
    static constexpr bool PERM = true, AFTER_DRAIN = false;
    bf16_t* H;
    __device__ __forceinline__ void operator()(const f32x4 (&acc)[2][2][4][2], const Unit& u, int wr, int wc, int fr, int fq) const {
        const int row0 = u.pm * BM + wr * 64 + fr, col0 = (u.pn & 7) * 128 + wc * 32 + 8 * fq;
#pragma unroll
        for (int ai = 0; ai < 2; ++ai)
#pragma unroll
            for (int m = 0; m < 4; ++m) { bf16_t* rowp = H + (size_t)(row0 + ai * HALF + m * 16) * EFF + col0;
                const f32x4 g0 = acc[ai][0][m][0], g1 = acc[ai][0][m][1], u0 = acc[ai][1][m][0], u1 = acc[ai][1][m][1];
                f32x4 h0, h1;
#pragma unroll
                for (int j = 0; j < 4; ++j) { h0[j] = silu_f(g0[j]) * u0[j]; h1[j] = silu_f(g1[j]) * u1[j]; }
                u32x4 w; w.x = cvt_pk_bf16(h0[0], h0[1]); w.y = cvt_pk_bf16(h0[2], h0[3]); w.z = cvt_pk_bf16(h1[0], h1[1]); w.w = cvt_pk_bf16(h1[2], h1[3]);
                *(u32x4*)rowp = w; }
    }
};
struct EpiMoe2 {
    static constexpr bool PERM = true, AFTER_DRAIN = false;
    bf16_t* Y;
    __device__ __forceinline__ void operator()(const f32x4 (&acc)[2][2][4][2], const Unit& u, int wr, int wc, int fr, int fq) const {
        const int row0 = u.pm * BM + wr * 64 + fr, col0 = (u.pn & 7) * BM + wc * 32 + 8 * fq;
#pragma unroll
        for (int ai = 0; ai < 2; ++ai)
#pragma unroll
            for (int m = 0; m < 4; ++m) { bf16_t* rowp = Y + (size_t)(row0 + ai * HALF + m * 16) * DM + col0;
#pragma unroll
                for (int bj = 0; bj < 2; ++bj) { const f32x4 v0 = acc[ai][bj][m][0], v1 = acc[ai][bj][m][1];
                    u32x4 w; w.x = cvt_pk_bf16(v0[0], v0[1]); w.y = cvt_pk_bf16(v0[2], v0[3]); w.z = cvt_pk_bf16(v1[0], v1[1]); w.w = cvt_pk_bf16(v1[2], v1[3]);
                    *(u32x4*)(rowp + bj * HALF) = w; } }
    }
};
struct MoeOrder {
    int G, c, ntot;
    __device__ bool next(int i, Unit& u) const {
        const long L = (long)i * G + c; if (L >= ntot) return false;
        if (L < 1024) {
            if (G == 256) {
                const int x = c & 7, j = c >> 3, e = i * 4 + (x >> 1); u.pm = e * 8 + (x & 1) * 4 + (j & 3); u.pn = e * 8 + (j >> 2); }
            else { const int e = (int)L >> 6, r = (int)L & 63; u.pm = e * 8 + (r & 7); u.pn = e * 8 + (r >> 3); } }
        else { const int Lc = (int)L - 1024, e = Lc >> 3; u.pm = 128 + e; u.pn = e * 8 + (Lc & 7); }
        return true;
    }
    __device__ __forceinline__ void a_ready(const Unit&) const {}
    __device__ __forceinline__ void done(const Unit&) const {}
};

template <class Epi, class Sched, bool ALIGN_EPI = false, bool SP2 = false, bool GATHER = false>
__device__ __forceinline__ void gemm_phase(PG8_LAS unsigned char* lds, const Gemm g, const Sched& S, const Epi& E, const int* rowsrc = nullptr) {
    static_assert(!GATHER || SP2, "gathered A rows are wired into the SP2 loop only");
    int tid_l = threadIdx.x; asm volatile("" : "+v"(tid_l));
    const int tid = tid_l, wid = __builtin_amdgcn_readfirstlane(tid >> 6), lane = tid & 63, wr = wid >> 2, wc = wid & 3, fr = lane & 15, fq = lane >> 4;
    const int K = g.K, nt = K / BK;
    unsigned voffA[2], voffB[2];
#pragma unroll
    for (int i = 0; i < 2; ++i) { int R, C; stage_rc(tid * 16 + i * 8192, R, C); const int Rb = Epi::PERM ? ((R & ~31) + perm32(R & 31)) : R;
        voffA[i] = (unsigned)(R * K + C) * 2u; voffB[i] = (unsigned)(Rb * K + C) * 2u; }
    const size_t kstep = (size_t)(BK * 2);
    const size_t hstep = (size_t)HALF * K * 2;
    const size_t tstep = 2 * hstep;
    const unsigned ldsw = (unsigned)wid * 1024u;
    const int aoff = lds_byte(wr * 64 + fr, fq * 8), boff = lds_byte(wc * 32 + fr, fq * 8);
#define PG8_SA(b, h) (((b) * 2 + (h)) * HTB)
#define PG8_SB(b, h) ((4 + (b) * 2 + (h)) * HTB)
#define PG8_STAGE(bufoff, gbase, voff) do { _Pragma("unroll") for (int _i = 0; _i < 2; ++_i) \
        __builtin_amdgcn_global_load_lds((const unsigned*)((const char*)(gbase) + (voff)[_i]), (PG8_LAS unsigned*)(lds + (bufoff) + ldsw + _i * 8192), 16, 0, 0); } while (0)
#define PG8_GOFF(u_, go_) do { _Pragma("unroll") for (int _h = 0; _h < 2; ++_h) _Pragma("unroll") for (int _i = 0; _i < 2; ++_i) { int R_, C_; stage_rc(tid * 16 + _i * 8192, R_, C_); \
        go_[_h][_i] = (unsigned)rowsrc[(u_).pm * BM + _h * HALF + R_] * (unsigned)(K * 2) + (unsigned)(C_ * 2); } } while (0)
#define PG8_STAGE_A(bufoff, gbase, h_, nx_) do { if constexpr (GATHER) { _Pragma("unroll") for (int _i = 0; _i < 2; ++_i) { const unsigned o_ = (nx_) ? goffN[h_][_i] : goffC[h_][_i]; \
        __builtin_amdgcn_global_load_lds((const unsigned*)((const char*)(gbase) + o_), (PG8_LAS unsigned*)(lds + (bufoff) + ldsw + _i * 8192), 16, 0, 0); } } \
    else { PG8_STAGE(bufoff, (gbase) + (h_) * hstep, voffA); } } while (0)
#define PG8_LDA(dst, b, h) do { _Pragma("unroll") for (int m = 0; m < 4; ++m) _Pragma("unroll") for (int k = 0; k < 2; ++k) dst[m][k] = *(const PG8_LAS bf16x8*)(lds + PG8_SA(b, h) + aoff + m * 2048 + k * 1024); } while (0)
#define PG8_LDB(dst, b, h) do { _Pragma("unroll") for (int n = 0; n < 2; ++n) _Pragma("unroll") for (int k = 0; k < 2; ++k) dst[n][k] = *(const PG8_LAS bf16x8*)(lds + PG8_SB(b, h) + boff + n * 2048 + k * 1024); } while (0)
#define PG8_MMA(ai, bj, At, Bt) do { __builtin_amdgcn_s_setprio(1); _Pragma("unroll") for (int m = 0; m < 4; ++m) _Pragma("unroll") for (int n = 0; n < 2; ++n) _Pragma("unroll") for (int k = 0; k < 2; ++k) \
        acc[ai][bj][m][n] = __builtin_amdgcn_mfma_f32_16x16x32_bf16(Bt[n][k], At[m][k], acc[ai][bj][m][n], 0, 0, 0); __builtin_amdgcn_s_setprio(0); } while (0)
#define PG8_WAIT_V(n) asm volatile("s_waitcnt vmcnt(" #n ")" ::: "memory")
#define PG8_WAIT_L(n) asm volatile("s_waitcnt lgkmcnt(" #n ")" ::: "memory")
#define PG8_BAR __builtin_amdgcn_s_barrier()
#define PG8_SCHED __builtin_amdgcn_sched_barrier(0)
    Unit cur, nxt; int ui = 0;
    if (!S.next(0, cur)) return;
    f32x4 acc[2][2][4][2];
#pragma unroll
    for (int a = 0; a < 2; ++a)
#pragma unroll
        for (int b = 0; b < 2; ++b)
#pragma unroll
            for (int m = 0; m < 4; ++m)
#pragma unroll
                for (int n = 0; n < 2; ++n) acc[a][b][m][n] = (f32x4){0.f, 0.f, 0.f, 0.f};
    bf16x8 At[4][2], B0[2][2], B1[2][2];
    const char* cA = GATHER ? (const char*)g.A : (const char*)g.A + (size_t)cur.pm * tstep; const char* cB = (const char*)g.Bt + (size_t)cur.pn * tstep;
    unsigned goffC[2][2] = {{0u, 0u}, {0u, 0u}}, goffN[2][2] = {{0u, 0u}, {0u, 0u}};
    if constexpr (GATHER) { PG8_GOFF(cur, goffC); }
    S.a_ready(cur);
    if constexpr (SP2) {
        PG8_STAGE(PG8_SB(0, 0), cB, voffB); PG8_STAGE(PG8_SB(0, 1), cB + hstep, voffB); PG8_STAGE_A(PG8_SA(0, 0), cA, 0, false); PG8_STAGE_A(PG8_SA(0, 1), cA, 1, false);
        if (wr == 1) PG8_BAR;
        PG8_WAIT_V(2); PG8_BAR;
        PG8_STAGE(PG8_SB(1, 0), cB + kstep, voffB); PG8_STAGE_A(PG8_SA(1, 0), cA + kstep, 0, false); PG8_STAGE(PG8_SB(1, 1), cB + hstep + kstep, voffB);
        PG8_WAIT_V(6); PG8_BAR;
    } else {
        PG8_STAGE(PG8_SB(0, 0), cB, voffB); PG8_STAGE(PG8_SA(0, 0), cA, voffA); PG8_STAGE(PG8_SB(0, 1), cB + hstep, voffB); PG8_STAGE(PG8_SA(0, 1), cA + hstep, voffA);
        if (wr == 1) PG8_BAR;
        PG8_WAIT_V(4); PG8_BAR;
        PG8_STAGE(PG8_SB(1, 0), cB + kstep, voffB); PG8_STAGE(PG8_SA(1, 0), cA + kstep, voffA); PG8_STAGE(PG8_SB(1, 1), cB + hstep + kstep, voffB);
        PG8_WAIT_V(6); PG8_BAR;
    }
    for (;;) {
        const bool has_next = S.next(ui + 1, nxt);
        const char* nA = GATHER ? cA : (has_next ? (const char*)g.A + (size_t)nxt.pm * tstep : cA);
        if constexpr (GATHER) { if (has_next) { PG8_GOFF(nxt, goffN); } else { _Pragma("unroll") for (int _h = 0; _h < 2; ++_h) _Pragma("unroll") for (int _i = 0; _i < 2; ++_i) goffN[_h][_i] = goffC[_h][_i]; } } const char* nB = has_next ? (const char*)g.Bt + (size_t)nxt.pn * tstep : cB;
        asm volatile(".p2align 9" ::: "memory");
        for (int t = 0; t < nt; t += 2) {
            const bool last = (t == nt - 2);
            const char* a1 = cA + (size_t)(t + 1) * kstep;
            const char* a2 = last ? nA : cA + (size_t)(t + 2) * kstep; const char* b2 = last ? nB : cB + (size_t)(t + 2) * kstep;
            const char* a3 = a2 + kstep; const char* b3 = b2 + kstep;
            if (last && has_next) S.a_ready(nxt);
            if constexpr (SP2) {
            PG8_LDB(B0, 0, 0); PG8_LDB(B1, 0, 1); PG8_SCHED; PG8_LDA(At, 0, 0); PG8_STAGE_A(PG8_SA(1, 1), a1, 1, false);
            PG8_WAIT_V(8); PG8_WAIT_L(0); PG8_BAR; PG8_MMA(0, 0, At, B0); PG8_MMA(0, 1, At, B1); PG8_BAR; PG8_SCHED;
            PG8_LDA(At, 0, 1); PG8_STAGE(PG8_SB(0, 0), b2, voffB); PG8_STAGE(PG8_SB(0, 1), b2 + hstep, voffB); PG8_STAGE_A(PG8_SA(0, 0), a2, 0, last);
            PG8_WAIT_V(8); PG8_WAIT_L(0); PG8_BAR; PG8_MMA(1, 0, At, B0); PG8_MMA(1, 1, At, B1); PG8_BAR; PG8_SCHED;
            PG8_LDB(B0, 1, 0); PG8_LDB(B1, 1, 1); PG8_SCHED; PG8_LDA(At, 1, 0); PG8_STAGE_A(PG8_SA(0, 1), a2, 1, last);
            PG8_WAIT_V(8); PG8_WAIT_L(0); PG8_BAR; PG8_MMA(0, 0, At, B0); PG8_MMA(0, 1, At, B1); PG8_BAR; PG8_SCHED;
            PG8_LDA(At, 1, 1); PG8_STAGE(PG8_SB(1, 0), b3, voffB); PG8_STAGE(PG8_SB(1, 1), b3 + hstep, voffB); PG8_STAGE_A(PG8_SA(1, 0), a3, 0, last);
            PG8_WAIT_V(8); PG8_WAIT_L(0); PG8_BAR; PG8_MMA(1, 0, At, B0); PG8_MMA(1, 1, At, B1); PG8_BAR; PG8_SCHED;
            } else {
            PG8_LDB(B0, 0, 0); PG8_SCHED; PG8_LDA(At, 0, 0); PG8_STAGE(PG8_SA(1, 1), a1 + hstep, voffA);
            PG8_WAIT_L(8); PG8_BAR; PG8_WAIT_L(0); PG8_MMA(0, 0, At, B0); PG8_BAR; PG8_SCHED;
            PG8_LDB(B1, 0, 1); PG8_STAGE(PG8_SB(0, 0), b2, voffB);
            PG8_BAR; PG8_WAIT_L(0); PG8_MMA(0, 1, At, B1); PG8_BAR;
            PG8_LDA(At, 0, 1); PG8_STAGE(PG8_SA(0, 0), a2, voffA);
            PG8_BAR; PG8_WAIT_L(0); PG8_MMA(1, 0, At, B0); PG8_BAR; PG8_SCHED;
            PG8_STAGE(PG8_SB(0, 1), b2 + hstep, voffB);
            PG8_WAIT_V(6); PG8_BAR; PG8_MMA(1, 1, At, B1); PG8_BAR;
            PG8_LDB(B0, 1, 0); PG8_SCHED; PG8_LDA(At, 1, 0); PG8_STAGE(PG8_SA(0, 1), a2 + hstep, voffA);
            PG8_WAIT_L(8); PG8_BAR; PG8_WAIT_L(0); PG8_MMA(0, 0, At, B0); PG8_BAR; PG8_SCHED;
            PG8_LDB(B1, 1, 1); PG8_STAGE(PG8_SB(1, 0), b3, voffB);
            PG8_BAR; PG8_WAIT_L(0); PG8_MMA(0, 1, At, B1); PG8_BAR;
            PG8_LDA(At, 1, 1); PG8_STAGE(PG8_SA(1, 0), a3, voffA);
            PG8_BAR; PG8_WAIT_L(0); PG8_MMA(1, 0, At, B0); PG8_BAR; PG8_SCHED;
            PG8_STAGE(PG8_SB(1, 1), b3 + hstep, voffB);
            PG8_WAIT_V(6); PG8_BAR; PG8_MMA(1, 1, At, B1); PG8_BAR;
            }
        }
        if constexpr (ALIGN_EPI) { if (wr == 0) PG8_BAR; }
        if constexpr (!Epi::AFTER_DRAIN) { E(acc, cur, wr, wc, fr, fq); S.done(cur); }
        if (!has_next) break;
#pragma unroll
        for (int a = 0; a < 2; ++a)
#pragma unroll
            for (int b = 0; b < 2; ++b)
#pragma unroll
                for (int m = 0; m < 4; ++m)
#pragma unroll
                    for (int n = 0; n < 2; ++n) acc[a][b][m][n] = (f32x4){0.f, 0.f, 0.f, 0.f};
        cur = nxt; cA = nA; cB = nB; ++ui;
        if constexpr (GATHER) { _Pragma("unroll") for (int _h = 0; _h < 2; ++_h) _Pragma("unroll") for (int _i = 0; _i < 2; ++_i) goffC[_h][_i] = goffN[_h][_i]; }
        if constexpr (ALIGN_EPI) { if (wr == 1) PG8_BAR; }
    }
    PG8_WAIT_V(0);
    if constexpr (!ALIGN_EPI) { if (wr == 0) PG8_BAR; }
    PG8_BAR;
    if constexpr (Epi::AFTER_DRAIN) { E.fused(acc, cur, wr, wc, fr, fq, lds, wid, lane); S.done(cur); }
#undef PG8_SA
#undef PG8_SB
#undef PG8_STAGE
#undef PG8_GOFF
#undef PG8_STAGE_A
#undef PG8_LDA
#undef PG8_LDB
#undef PG8_MMA
#undef PG8_WAIT_V
#undef PG8_WAIT_L
#undef PG8_BAR
#undef PG8_SCHED
}
}

constexpr size_t MiB = 1u << 20;
constexpr size_t WS_CTL = 0, CTL_ZERO_BYTES = 1 * MiB;
constexpr size_t WS_MOD = 1 * MiB;
constexpr size_t WS_RWT = WS_MOD + 512 * 1024;
constexpr size_t WS_AFF = 2 * MiB;
constexpr size_t WS_PART = WS_AFF;
constexpr size_t WS_AFFC = WS_AFF + (size_t)NBATCH * NEXP * SEQ * 4;
constexpr size_t WS_IDX = 4 * MiB;
constexpr size_t WS_IDXC = WS_IDX + 32 * 1024 * 4, WS_GATE = WS_IDXC + 32 * 32 * 4, WS_GATEC = WS_GATE + 32 * 1024 * 4;
constexpr size_t WS_ROWSRC = WS_IDX + 512 * 1024;
constexpr size_t WS_INV = 5 * MiB;
constexpr size_t WS_HD = 7 * MiB;
constexpr size_t WS_WIN = 10 * MiB;
constexpr size_t WS_WOUT = 66 * MiB;
constexpr size_t WS_WGU = 82 * MiB;
constexpr size_t WS_WD = 338 * MiB;
constexpr size_t WS_R1 = 466 * MiB;
constexpr size_t WS_R2C = 598 * MiB;
constexpr size_t WS_XM = 602 * MiB;
constexpr size_t WS_STAGE = 668 * MiB;
constexpr size_t WS_QKV = WS_STAGE;
constexpr size_t WS_CG = WS_QKV + 3 * (size_t)MROWS * 1024 * 2;
constexpr size_t WS_GF = WS_CG + 6 * (size_t)MROWS * 512 * 2;
constexpr size_t WS_MIX = WS_GF + 2 * (size_t)MROWS * 512 * 4;
constexpr size_t WS_HU = WS_MIX + (size_t)MROWS * 2048 * 2;
constexpr size_t WS_HS = WS_HU + (size_t)NSCAN * NCHUNK * 16384 * 4;
constexpr size_t WS_STAGE_END = WS_HS + (size_t)NSCAN * NCHUNK * 16384 * 2;
constexpr size_t WS_Z = WS_R1;
constexpr size_t WS_XG = WS_STAGE;
constexpr size_t WS_HID = WS_XG + (size_t)XG_ROWS * 2048 * 2;
constexpr size_t WS_Y = WS_HID + (size_t)XG_ROWS * 1024 * 2;
constexpr size_t WS_MOE_END = WS_Y + (size_t)XG_ROWS * 2048 * 2;
constexpr size_t WS_END = WS_STAGE_END > WS_MOE_END ? WS_STAGE_END : WS_MOE_END;
static_assert(WS_WIN + (size_t)DEPTH * PROJ_W * DM * 2 <= WS_WOUT && WS_WOUT + (size_t)DEPTH * DM * DM * 2 <= WS_WGU && WS_WGU + (size_t)DEPTH * NEXP * 2048 * 2048 * 2 <= WS_WD &&
              WS_WD + (size_t)DEPTH * NEXP * 2048 * 1024 * 2 <= WS_R1 && WS_R1 + (size_t)MROWS * DM * 4 <= WS_R2C && WS_R2C + (size_t)NCTX * DM * 4 <= WS_XM && WS_XM + (size_t)MROWS * DM * 2 <= WS_STAGE, "d_ws map");
static_assert(WS_PART + (size_t)DEPTH * 16 * 3 * 12288 * 4 <= WS_HD && WS_AFFC + (size_t)NBATCH * NEXP * CTXL * 4 <= WS_IDX && WS_GATEC + 32 * 32 * 4 <= WS_INV && WS_INV + (size_t)MROWS * 16 * 4 <= WS_HD && WS_HD + (size_t)NSCAN * NCHUNK * 128 * 4 <= WS_WIN, "d_ws small map");
static_assert(WS_END <= (size_t)1236 * MiB, "d_ws must fit in sum(inputs) = 1236.4 MiB");
constexpr int CW_BAR = 4096;

constexpr int RING_BYTES = 131072;
constexpr int MISC_OFF = RING_BYTES + 320;
constexpr int LDS_BYTES = 151552;
constexpr int SPARE_OFF = RING_BYTES + 1024;
constexpr int NWAVES = 8;

#define GAS __attribute__((address_space(1)))
#define LAS __attribute__((address_space(3)))
typedef unsigned short bf16;
typedef unsigned v4u __attribute__((ext_vector_type(4)));
typedef unsigned v2u __attribute__((ext_vector_type(2)));
typedef float f32x4 __attribute__((ext_vector_type(4)));
typedef float f32x2 __attribute__((ext_vector_type(2)));
typedef short bf16x8 __attribute__((ext_vector_type(8)));
#define LDS_WAIT() asm volatile("s_waitcnt lgkmcnt(0)" ::: "memory")
#define VM_WAIT() asm volatile("s_waitcnt vmcnt(0)" ::: "memory")
#define LDS_BARRIER() asm volatile("s_waitcnt lgkmcnt(0)\n\ts_barrier" ::: "memory")
__device__ __forceinline__ unsigned f2bf(float f) { unsigned u = __builtin_bit_cast(unsigned, f); return (u + 0x7fffu + ((u >> 16) & 1u)) >> 16; }
__device__ __forceinline__ unsigned pk2(float lo, float hi) { return f2bf(lo) | (f2bf(hi) << 16); }
__device__ __forceinline__ float bf2f(unsigned short b) { return __builtin_bit_cast(float, ((unsigned)b) << 16); }
__device__ __forceinline__ float bflo(unsigned w) { return __builtin_bit_cast(float, w << 16); }
__device__ __forceinline__ float bfhi(unsigned w) { return __builtin_bit_cast(float, w & 0xffff0000u); }
__device__ __forceinline__ float wave_sum(float v) {
#pragma unroll
    for (int o = 1; o < 64; o <<= 1) v += __shfl_xor(v, o);
    return v;
}
__device__ __forceinline__ float sigmoid_f(float z) { return 1.0f / (1.0f + expf(-z)); }

#define XB_TMO      128
#define XB_XCNT(j)  (256  + 64 * (j))
#define XB_XSUB(j)  (1280 + 64 * (j))
#define XB_XGEN(j)  (2304 + 64 * (j))
#define XB_TOP      3328
#define XB_TOPGEN   3392
#define XCD_BAR_WORDS 3456
#define XB_SPIN_CAP (1u << 18)

__device__ __forceinline__ unsigned xb_ld(unsigned* p)              { return __hip_atomic_load(p, __ATOMIC_RELAXED, __HIP_MEMORY_SCOPE_AGENT); }
__device__ __forceinline__ unsigned xb_add(unsigned* p, unsigned v) { return __hip_atomic_fetch_add(p, v, __ATOMIC_RELAXED, __HIP_MEMORY_SCOPE_AGENT); }
__device__ __forceinline__ unsigned xb_xcc_id() { return (unsigned)__builtin_amdgcn_s_getreg((3 << 11) | 20) & 0xFu; }
#define XB_SPIN(cond, bar) do { unsigned _sp = 0; while (cond) { __builtin_amdgcn_s_sleep(1); \
    if ((++_sp & 255u) == 0u) { if (xb_ld(&(bar)[XB_TMO])) break; if (_sp > XB_SPIN_CAP) { atomicAdd(&(bar)[XB_TMO], 1u); break; } } } } while (0)

struct XcdBarrier {
    unsigned* bar; unsigned x;
    volatile LAS unsigned* st;
};

__device__ __forceinline__ XcdBarrier xcd_barrier_post(unsigned* bar, volatile LAS unsigned* st) {
    XcdBarrier b; b.bar = bar; b.x = xb_xcc_id(); b.st = st;
    if (threadIdx.x == 0) (void)xb_add(&bar[XB_XCNT(b.x)], 1u);
    return b;
}
__device__ __forceinline__ void xcd_barrier_complete(unsigned* bar, unsigned x, unsigned& nloc, unsigned& nx) {
    const unsigned G = gridDim.x * gridDim.y * gridDim.z;
    unsigned sum, cnt, mine, sp = 0u;
    for (;;) {
        sum = 0u; cnt = 0u; mine = 0u;
#pragma unroll
        for (unsigned j = 0; j < 16; ++j) { const unsigned c = xb_ld(&bar[XB_XCNT(j)]); sum += c; cnt += (c > 0u) ? 1u : 0u; mine = (j == x) ? c : mine; }
        if (sum == G) break;
        __builtin_amdgcn_s_sleep(1);
        if ((++sp & 255u) == 0u) { if (xb_ld(&bar[XB_TMO])) break; if (sp > XB_SPIN_CAP) { atomicAdd(&bar[XB_TMO], 1u); break; } }
    }
    nloc = mine > 0u ? mine : 1u; nx = cnt > 0u ? cnt : 1u;
}

__device__ __forceinline__ void xcd_barrier(const XcdBarrier& b) {
    asm volatile("s_waitcnt vmcnt(0)" ::: "memory");
    __syncthreads();
    if (threadIdx.x == 0) {
        unsigned* bar = b.bar;
        __builtin_amdgcn_s_waitcnt(0);
        unsigned nloc = b.st[0], nx = b.st[1];
        if (nloc == 0u) { xcd_barrier_complete(bar, b.x, nloc, nx); b.st[0] = nloc; b.st[1] = nx; }
        const unsigned old = xb_add(&bar[XB_XSUB(b.x)], 1u);
        const unsigned gen = old / nloc;
        if (old + 1u == (gen + 1u) * nloc) {
            __builtin_amdgcn_fence(__ATOMIC_RELEASE, "agent");
            asm volatile("s_waitcnt vmcnt(0)" ::: "memory");
            const unsigned og = xb_add(&bar[XB_TOP], 1u);
            const unsigned tg = og / nx;
            if (og + 1u == (tg + 1u) * nx) xb_add(&bar[XB_TOPGEN], 1u);
            else XB_SPIN(xb_ld(&bar[XB_TOPGEN]) == tg, bar);
            __builtin_amdgcn_fence(__ATOMIC_ACQUIRE, "agent");
            xb_add(&bar[XB_XGEN(b.x)], 1u);
            asm volatile("s_waitcnt vmcnt(0)" ::: "memory");
        } else {
            XB_SPIN(xb_ld(&bar[XB_XGEN(b.x)]) == gen, bar);
            __builtin_amdgcn_fence(__ATOMIC_ACQUIRE, "agent");
            asm volatile("s_waitcnt vmcnt(0)" ::: "memory");
        }
    }
    __syncthreads();
}


namespace att {
typedef short s16x4 __attribute__((ext_vector_type(4)));
typedef float f32x16 __attribute__((ext_vector_type(16)));
typedef unsigned u32x4 __attribute__((ext_vector_type(4)));
constexpr int KVBLK = 64, LDK = 1024;
constexpr float SCALE = 0.125f;
constexpr float THR = 8.f;
constexpr int SHM_V = KVBLK * 128 * 2, SHM_K = KVBLK * 128 * 2, SHM_ATTN = 2 * SHM_V + 2 * SHM_K + NWAVES * 64 * 4;
#define KSWZ(row, colB) ((row) * 256 + ((colB) ^ (((row) & 7) << 4)))
#define SBAR() __builtin_amdgcn_sched_barrier(0)
__device__ __forceinline__ int crow(int r, int hi) { return (r & 3) + 8 * (r >> 2) + 4 * hi; }
__device__ __forceinline__ unsigned cvtpk(float lo, float hi) { unsigned r; asm volatile("v_cvt_pk_bf16_f32 %0, %1, %2" : "=v"(r) : "v"(lo), "v"(hi)); return r; }
__device__ __forceinline__ void partialSM(f32x16& p0, f32x16& p1, float& m_reg, float& mn, float& alpha) {
  constexpr float C = SCALE * 1.4426950408889634f;
  float pmax = p0[0]; for (int r = 1; r < 16; ++r) pmax = fmaxf(pmax, p0[r]); for (int r = 0; r < 16; ++r) pmax = fmaxf(pmax, p1[r]);
  { auto rr = __builtin_amdgcn_permlane32_swap(__float_as_uint(pmax), __float_as_uint(pmax), false, false);
    pmax = fmaxf(__uint_as_float(rr[0]), __uint_as_float(rr[1])); }
  if (__builtin_expect(__all(pmax - m_reg <= THR / SCALE), 1)) { mn = m_reg; alpha = 1.f; }
  else { mn = fmaxf(m_reg, pmax); alpha = __builtin_amdgcn_exp2f((m_reg - mn) * C); m_reg = mn; }
  float mnC = -mn * C;
  for (int r = 0; r < 16; ++r) p0[r] = fmaf(p0[r], C, mnC); for (int r = 0; r < 16; ++r) p1[r] = fmaf(p1[r], C, mnC);
  for (int r = 0; r < 16; ++r) p0[r] = __builtin_amdgcn_exp2f(p0[r]);
}
__device__ __forceinline__ void finishSM(f32x16& p0, f32x16& p1, float alpha, float& l_reg, bf16x8& pa0, bf16x8& pa1, bf16x8& pa2, bf16x8& pa3) {
  for (int r = 0; r < 16; ++r) p1[r] = __builtin_amdgcn_exp2f(p1[r]);
  float ps = 0; for (int r = 0; r < 16; ++r) ps += p0[r]; for (int r = 0; r < 16; ++r) ps += p1[r];
  { auto rr = __builtin_amdgcn_permlane32_swap(__float_as_uint(ps), __float_as_uint(ps), false, false);
    ps = __uint_as_float(rr[0]) + __uint_as_float(rr[1]); }
  l_reg = l_reg * alpha + ps;
#define PK4(P, BASE, OUT) do { unsigned a0 = cvtpk(P[BASE + 0], P[BASE + 1]), a1 = cvtpk(P[BASE + 2], P[BASE + 3]);   \
    unsigned b0 = cvtpk(P[BASE + 4], P[BASE + 5]), b1 = cvtpk(P[BASE + 6], P[BASE + 7]);                              \
    auto r0 = __builtin_amdgcn_permlane32_swap(a0, b0, false, false); auto r1 = __builtin_amdgcn_permlane32_swap(a1, b1, false, false); \
    u32x4 w = {r0[0], r1[0], r0[1], r1[1]}; OUT = *reinterpret_cast<bf16x8*>(&w); } while (0)
  PK4(p0, 0, pa0); PK4(p0, 8, pa1); PK4(p1, 0, pa2); PK4(p1, 8, pa3);
#undef PK4
}
__device__ __forceinline__ void kload(bf16x8 (&kf)[8], const char* Ks, int r32, int hi, int sb) {
#pragma unroll
  for (int d0 = 0; d0 < 4; ++d0) { const int cb = sb + (d0 * 16 + hi * 8) * 2;
    kf[2 * d0] = *reinterpret_cast<const bf16x8*>(Ks + KSWZ(r32, cb)); kf[2 * d0 + 1] = *reinterpret_cast<const bf16x8*>(Ks + KSWZ(32 + r32, cb)); }
}
__device__ __forceinline__ void kmma(f32x16& p0, f32x16& p1, const bf16x8 (&kf)[8], const bf16x8* qr) {
  asm volatile("s_waitcnt lgkmcnt(0)" ::: "memory"); SBAR();
  p0 = f32x16{}; p1 = f32x16{};
#pragma unroll
  for (int d0 = 0; d0 < 4; ++d0) { p0 = __builtin_amdgcn_mfma_f32_32x32x16_bf16(kf[2 * d0], qr[d0], p0, 0, 0, 0); p1 = __builtin_amdgcn_mfma_f32_32x32x16_bf16(kf[2 * d0 + 1], qr[d0], p1, 0, 0, 0); }
}
__device__ __forceinline__ void qkt(f32x16& p0, f32x16& p1, const char* Ks, const bf16x8* qr, int r32, int hi, int sb) {
  bf16x8 kf[8]; kload(kf, Ks, r32, hi, sb); SBAR(); kmma(p0, p1, kf, qr);
}
__device__ __forceinline__ int v_st(int k, int c) { const int kk = (k & ~0xC) | ((k & 4) << 1) | ((k & 8) >> 1); return ((kk >> 3) * 4 + (c >> 5)) * 512 + ((kk & 7) * 32 + (c & 31)) * 2; }
__device__ __forceinline__ int v_rd_base(int lane) { return ((lane & 3) << 3) | (((lane >> 2) & 3) << 6) | (((lane >> 4) & 1) << 5) | (((lane >> 5) & 1) << 8); }
constexpr int v_rd_off(int d0, int ks, int half) { return d0 * 512 + ks * 4096 + half * 2048; }
template <int OFF> __device__ __forceinline__ s16x4 tr_read(int vb) {
  s16x4 r; asm volatile("ds_read_b64_tr_b16 %0, %1 offset:%2" : "=&v"(r) : "v"(vb), "i"(OFF) : "memory"); return r;
}
struct VFrag { s16x4 l0, h0, l1, h1, l2, h2, l3, h3; };
template <int D0> __device__ __forceinline__ void v_frag_read(VFrag& f, int vb) {
  f.l0 = tr_read<v_rd_off(D0, 0, 0)>(vb); f.h0 = tr_read<v_rd_off(D0, 0, 1)>(vb); f.l1 = tr_read<v_rd_off(D0, 1, 0)>(vb); f.h1 = tr_read<v_rd_off(D0, 1, 1)>(vb);
  f.l2 = tr_read<v_rd_off(D0, 2, 0)>(vb); f.h2 = tr_read<v_rd_off(D0, 2, 1)>(vb); f.l3 = tr_read<v_rd_off(D0, 3, 0)>(vb); f.h3 = tr_read<v_rd_off(D0, 3, 1)>(vb);
}
__device__ __forceinline__ void pv_mma(f32x16& od, const VFrag& f, bf16x8 pa0, bf16x8 pa1, bf16x8 pa2, bf16x8 pa3) {
#define PK(L, H) (bf16x8){L[0], L[1], L[2], L[3], H[0], H[1], H[2], H[3]}
  od = __builtin_amdgcn_mfma_f32_32x32x16_bf16(pa0, PK(f.l0, f.h0), od, 0, 0, 0);
  od = __builtin_amdgcn_mfma_f32_32x32x16_bf16(pa1, PK(f.l1, f.h1), od, 0, 0, 0);
  od = __builtin_amdgcn_mfma_f32_32x32x16_bf16(pa2, PK(f.l2, f.h2), od, 0, 0, 0);
  od = __builtin_amdgcn_mfma_f32_32x32x16_bf16(pa3, PK(f.l3, f.h3), od, 0, 0, 0);
#undef PK
}
__device__ __forceinline__ void pv_d0(f32x16* o, int vb, bf16x8 pa0, bf16x8 pa1, bf16x8 pa2, bf16x8 pa3) {
  VFrag fa, fb;
  v_frag_read<0>(fa, vb);
  asm volatile("s_waitcnt lgkmcnt(0)" ::: "memory"); SBAR();
  v_frag_read<1>(fb, vb); SBAR();
  pv_mma(o[0], fa, pa0, pa1, pa2, pa3); SBAR();
  asm volatile("s_waitcnt lgkmcnt(0)" ::: "memory"); SBAR();
  v_frag_read<2>(fa, vb); SBAR();
  pv_mma(o[1], fb, pa0, pa1, pa2, pa3); SBAR();
  asm volatile("s_waitcnt lgkmcnt(0)" ::: "memory"); SBAR();
  v_frag_read<3>(fb, vb); SBAR();
  pv_mma(o[2], fa, pa0, pa1, pa2, pa3); SBAR();
  asm volatile("s_waitcnt lgkmcnt(0)" ::: "memory"); SBAR();
  pv_mma(o[3], fb, pa0, pa1, pa2, pa3);
}

constexpr int NKS = 3, NVS = 4, LDS_KR = 0, LDS_VR = NKS * SHM_K, LDS_WS = LDS_VR + NVS * SHM_V;
__device__ __forceinline__ void attn_unit(const bf16* __restrict__ Qb, const bf16* __restrict__ Kh, const bf16* __restrict__ Vh, int klat0, int nlt, int kctx0, int NT,
                                          float lam, float post, const float* __restrict__ subw, bf16* __restrict__ Ob, char* lds) {
  int tid_l = threadIdx.x; asm volatile("" : "+v"(tid_l));
  const int tid = tid_l, wid = __builtin_amdgcn_readfirstlane(tid >> 6), lane = tid & 63, r32 = lane & 31, hi = lane >> 5;
  const int sbr = wid >> 2, wq = wid & 3, sb = sbr * 128;
  char* K_lds = lds + LDS_KR; char* V_lds = lds + LDS_VR;
  float* ws = (float*)(lds + LDS_WS) + wid * 64; float* li_l = ws; float* al_l = ws + 32;
  float m_reg = -1e30f, l_reg = 0; f32x16 o[4] = {}; bf16x8 qr[4];
  const bf16* Qw = Qb + (long)(wq * 32 + r32) * LDK + sbr * 64 + hi * 8;
#pragma unroll
  for (int d0 = 0; d0 < 4; ++d0) qr[d0] = *reinterpret_cast<const bf16x8*>(Qw + d0 * 16);
  unsigned koff[2], voff[2];
#pragma unroll
  for (int q = 0; q < 2; ++q) { const int ch = (q * 8 + wid) * 64 + lane;
    { const int row = ch >> 4, cpos = ch & 15, csrc = cpos ^ (row & 7); koff[q] = (unsigned)(row * LDK + csrc * 8) * 2u; }
    { const int pb = ch * 16, sub = pb >> 9, within = (pb & 511) >> 1, kk = (sub >> 2) * 8 + (within >> 5), c = (sub & 3) * 32 + (within & 31);
      const int k = (kk & ~0xC) | ((kk & 4) << 1) | ((kk & 8) >> 1); voff[q] = (unsigned)(k * LDK + c) * 2u; } }
  const int vb0 = (int)(uintptr_t)V_lds + v_rd_base(lane);
  const unsigned ldsw = (unsigned)wid * 1024u;
  typedef __attribute__((address_space(3))) unsigned lds_u32;
#define KROW(jt) ((jt) < nlt ? (long)klat0 + (long)(jt) * KVBLK : (long)kctx0 + (long)((jt) - nlt) * KVBLK)
#define DMA_TILE(jt) do { const long kb_ = KROW(jt) * (LDK * 2); const char* kg_ = (const char*)Kh + kb_; const char* vg_ = (const char*)Vh + kb_; \
    const unsigned ks_ = (unsigned)(((jt) % NKS) * SHM_K) + ldsw, vs_ = (unsigned)(LDS_VR + ((jt) % NVS) * SHM_V) + ldsw; \
    _Pragma("unroll") for (int q_ = 0; q_ < 2; ++q_) { \
      __builtin_amdgcn_global_load_lds((const unsigned*)(kg_ + koff[q_]), (lds_u32*)(uintptr_t)((unsigned)(uintptr_t)lds + ks_ + q_ * 8192u), 16, 0, 0); \
      __builtin_amdgcn_global_load_lds((const unsigned*)(vg_ + voff[q_]), (lds_u32*)(uintptr_t)((unsigned)(uintptr_t)lds + vs_ + q_ * 8192u), 16, 0, 0); } } while (0)
#define TILE_BAR(n) do { asm volatile("s_waitcnt vmcnt(" #n ")" ::: "memory"); __builtin_amdgcn_s_barrier(); asm volatile("" ::: "memory"); } while (0)
#define RESC(a) do { if (__any((a) < 1.f)) { if (hi == 0) al_l[r32] = (a); asm volatile("s_waitcnt lgkmcnt(0)" ::: "memory"); \
    for (int d = 0; d < 4; ++d) for (int r = 0; r < 16; ++r) o[d][r] *= al_l[crow(r, hi)]; } } while (0)
#define KS(jt) (K_lds + ((jt) % NKS) * SHM_K)
#define VB(jt) (vb0 + ((jt) % NVS) * SHM_V)
  f32x16 pA0, pA1, pB0, pB1; float mnA, mnB, alA, alB; bf16x8 pa0, pa1, pa2, pa3;
  DMA_TILE(0); DMA_TILE(1); TILE_BAR(4);
  DMA_TILE(2);
  qkt(pA0, pA1, KS(0), qr, r32, hi, sb); partialSM(pA0, pA1, m_reg, mnA, alA);
  TILE_BAR(4);
  if (sbr == 0) {
    asm volatile(".p2align 8" ::: "memory");
    for (int j = 1; j + 1 < NT; j += 2) {
      if (j + 2 < NT) DMA_TILE(j + 2);
      SBAR(); qkt(pB0, pB1, KS(j), qr, r32, hi, sb);
      finishSM(pA0, pA1, alA, l_reg, pa0, pa1, pa2, pa3); SBAR();
      pv_d0(o, VB(j - 1), pa0, pa1, pa2, pa3); partialSM(pB0, pB1, m_reg, mnB, alB);
      RESC(alB);
      if (j + 2 < NT) TILE_BAR(4); else TILE_BAR(0);
      if (j + 3 < NT) DMA_TILE(j + 3);
      SBAR(); qkt(pA0, pA1, KS(j + 1), qr, r32, hi, sb);
      finishSM(pB0, pB1, alB, l_reg, pa0, pa1, pa2, pa3); SBAR();
      pv_d0(o, VB(j), pa0, pa1, pa2, pa3); partialSM(pA0, pA1, m_reg, mnA, alA);
      RESC(alA);
      if (j + 3 < NT) TILE_BAR(4); else TILE_BAR(0);
    }
  } else {
    asm volatile(".p2align 8" ::: "memory");
    for (int j = 1; j + 1 < NT; j += 2) {
      if (j + 2 < NT) DMA_TILE(j + 2);
      bf16x8 kf[8];
      SBAR(); kload(kf, KS(j), r32, hi, sb); SBAR();
      finishSM(pA0, pA1, alA, l_reg, pa0, pa1, pa2, pa3); SBAR();
      kmma(pB0, pB1, kf, qr); SBAR();
      partialSM(pB0, pB1, m_reg, mnB, alB); SBAR();
      pv_d0(o, VB(j - 1), pa0, pa1, pa2, pa3);
      RESC(alB);
      if (j + 2 < NT) TILE_BAR(4); else TILE_BAR(0);
      if (j + 3 < NT) DMA_TILE(j + 3);
      SBAR(); kload(kf, KS(j + 1), r32, hi, sb); SBAR();
      finishSM(pB0, pB1, alB, l_reg, pa0, pa1, pa2, pa3); SBAR();
      kmma(pA0, pA1, kf, qr); SBAR();
      partialSM(pA0, pA1, m_reg, mnA, alA); SBAR();
      pv_d0(o, VB(j), pa0, pa1, pa2, pa3);
      RESC(alA);
      if (j + 3 < NT) TILE_BAR(4); else TILE_BAR(0);
    }
  }
  SBAR(); qkt(pB0, pB1, KS(NT - 1), qr, r32, hi, sb);
  finishSM(pA0, pA1, alA, l_reg, pa0, pa1, pa2, pa3); SBAR();
  pv_d0(o, VB(NT - 2), pa0, pa1, pa2, pa3); partialSM(pB0, pB1, m_reg, mnB, alB);
  RESC(alB);
  finishSM(pB0, pB1, alB, l_reg, pa0, pa1, pa2, pa3); SBAR();
  pv_d0(o, VB(NT - 1), pa0, pa1, pa2, pa3);
  if (hi == 0) li_l[r32] = l_reg; asm volatile("s_waitcnt lgkmcnt(0)" ::: "memory");
  int hi_e = hi, r32_e = r32, wq_e = wq;
  asm volatile("" : "+v"(hi_e), "+v"(r32_e), "+v"(wq_e));
  float rli[16];
#pragma unroll
  for (int r = 0; r < 16; ++r) rli[r] = 1.0f / li_l[crow(r, hi_e)];
#pragma unroll
  for (int d0 = 0; d0 < 4; ++d0)
#pragma unroll
    for (int r = 0; r < 16; ++r) o[d0][r] *= rli[r];
  asm volatile("s_waitcnt vmcnt(0)" ::: "memory");
  __syncthreads();
  float* X = (float*)lds;
  if (sbr == 1) {
#pragma unroll
    for (int d0 = 0; d0 < 4; ++d0)
#pragma unroll
      for (int r = 0; r < 16; ++r) X[(wq_e * 32 + crow(r, hi_e)) * 128 + d0 * 32 + r32_e] = o[d0][r];
  }
  __syncthreads();
  if (sbr == 0) {
    float sw[4];
#pragma unroll
    for (int d0 = 0; d0 < 4; ++d0) sw[d0] = subw[d0 * 32 + r32_e] * post;
    bf16* Ow = Ob + (long)(wq_e * 32) * DM;
#pragma unroll
    for (int r = 0; r < 16; ++r) { const int orow = crow(r, hi_e); float v[4]; float ss = 0.f;
#pragma unroll
      for (int d0 = 0; d0 < 4; ++d0) { v[d0] = o[d0][r] - lam * X[(wq_e * 32 + orow) * 128 + d0 * 32 + r32_e]; ss += v[d0] * v[d0]; }
      ss += __shfl_xor(ss, 1); ss += __shfl_xor(ss, 2); ss += __shfl_xor(ss, 4); ss += __shfl_xor(ss, 8); ss += __shfl_xor(ss, 16);
      const float rs = 1.0f / sqrtf(ss * (1.0f / 128.0f) + LN_EPS);
#pragma unroll
      for (int d0 = 0; d0 < 4; ++d0) Ow[(long)orow * DM + d0 * 32 + r32_e] = (bf16)f2bf(v[d0] * rs * sw[d0]); }
  }
  __syncthreads();
#undef KROW
#undef DMA_TILE
#undef TILE_BAR
#undef KS
#undef VB
#undef RESC
}
#undef KSWZ
}


struct Frame {
    LAS unsigned char* lds; char* ldsg;
    int tid, lane, wave, vcu, G;
    unsigned char* ws;
    const float *x, *c, *ctx, *c_ctx, *w_mod, *b_mod, *w_in, *w_conv, *lambda_qk, *subln_w, *lb_logits, *hgrn_norm_w, *w_out, *ln_w, *ln_b, *w_router, *w_gate, *w_up, *w_down;
    float* out;
};
__device__ __forceinline__ float lambda_init_of(int l) { return l == 0 ? 0.2f : 0.35550906759096926f; }

__device__ __forceinline__ void p0_transpose_item(const float* W, int K, int N, bf16* WT, int row_off, int mode, LAS float* scr, int item, int lane) {
    const int nblk = N / 32, kb = item / nblk, nb = item % nblk, k0 = 64 * kb, n0 = 32 * nb;
    float wv[32];
    const float* wp = W + (size_t)(k0 + (lane >> 5)) * N + n0 + (lane & 31);
#pragma unroll
    for (int i = 0; i < 32; ++i) wv[i] = wp[(size_t)(2 * i) * N];
#pragma unroll
    for (int i = 0; i < 32; ++i) { const int kk = 2 * i + (lane >> 5); scr[kk * 33 + (lane & 31)] = wv[i]; }
    LDS_WAIT(); asm volatile("" ::: "memory");
    const int cch = lane & 7;
#pragma unroll
    for (int j = 0; j < 4; ++j) { const int n = (lane >> 3) + 8 * j; const LAS float* s = scr + (8 * cch) * 33 + n;
        v4u o; o.x = pk2(s[0 * 33], s[1 * 33]); o.y = pk2(s[2 * 33], s[3 * 33]); o.z = pk2(s[4 * 33], s[5 * 33]); o.w = pk2(s[6 * 33], s[7 * 33]);
        const int nn = n0 + n; const int drow = mode ? (row_off + (nn >> 7) * 256 + (nn & 127)) : (row_off + nn);
        *(GAS v4u*)(WT + (size_t)drow * K + k0 + 8 * cch) = o; }
    LDS_WAIT(); asm volatile("" ::: "memory");
}
constexpr int CV_I_IN = (DM / 64) * (PROJ_W / 32), CV_I_OUT = (DM / 64) * (DM / 32), CV_I_GU = (DM / 64) * (EFF / 32), CV_I_DN = (EFF / 64) * (DM / 32);
constexpr int CV_N_IN = DEPTH * CV_I_IN, CV_N_OUT = DEPTH * CV_I_OUT, CV_N_G = DEPTH * NEXP * CV_I_GU, CV_N_D = DEPTH * NEXP * CV_I_DN;
constexpr int CV_NITEMS = CV_N_IN + CV_N_OUT + 2 * CV_N_G + CV_N_D;
constexpr int CV_DEFER0 = CV_I_IN + CV_I_OUT;
constexpr int CV_DEFER = DEPTH * 3 * NEXP * 1024;
constexpr int CV_P0E = 27968;
constexpr int CV_S1 = CV_P0E + 20800, CV_S2 = CV_S1 + 21120, CV_S3 = CV_S2 + 6144, CV_S4 = CV_S3 + 3072;
static_assert(CV_S2 >= 3 * NEXP * 1024 && CV_S4 + 19200 == CV_DEFER && CV_P0E <= 3 * NEXP * 1024, "the first layer's expert weights must be complete before its expert GEMMs");
static_assert(CV_I_GU == 1024 && CV_I_DN == 1024 && DEPTH == 2, "deferred-item numbering");
__device__ __forceinline__ void convert_item(Frame& F, int it) {
    LAS float* scr = (LAS float*)(F.lds + F.wave * 8704);
    bf16* WIN = (bf16*)(F.ws + WS_WIN); bf16* WOUT = (bf16*)(F.ws + WS_WOUT); bf16* WGU = (bf16*)(F.ws + WS_WGU); bf16* WD = (bf16*)(F.ws + WS_WD);
    int r = it;
    if (r < CV_N_IN) { const int l = r / CV_I_IN; p0_transpose_item(F.w_in + (size_t)l * DM * PROJ_W, DM, PROJ_W, WIN + (size_t)l * PROJ_W * DM, 0, 0, scr, r % CV_I_IN, F.lane); return; } r -= CV_N_IN;
    if (r < CV_N_OUT) { const int l = r / CV_I_OUT; p0_transpose_item(F.w_out + (size_t)l * DM * DM, DM, DM, WOUT + (size_t)l * DM * DM, 0, 0, scr, r % CV_I_OUT, F.lane); return; } r -= CV_N_OUT;
    if (r < CV_N_G) { const int le = r / CV_I_GU; p0_transpose_item(F.w_gate + (size_t)le * DM * EFF, DM, EFF, WGU + (size_t)le * 2048 * DM, 0, 1, scr, r % CV_I_GU, F.lane); return; } r -= CV_N_G;
    if (r < CV_N_G) { const int le = r / CV_I_GU; p0_transpose_item(F.w_up + (size_t)le * DM * EFF, DM, EFF, WGU + (size_t)le * 2048 * DM, 128, 1, scr, r % CV_I_GU, F.lane); return; } r -= CV_N_G;
    { const int le = r / CV_I_DN; p0_transpose_item(F.w_down + (size_t)le * EFF * DM, EFF, DM, WD + (size_t)le * DM * EFF, 0, 0, scr, r % CV_I_DN, F.lane); }
}
struct CvDesc { const float* W; bf16* WT; int K, N, row_off, mode, k0, n0; };
__device__ __forceinline__ CvDesc cv_desc(const Frame& F, int it) {
    bf16* WIN = (bf16*)(F.ws + WS_WIN); bf16* WOUT = (bf16*)(F.ws + WS_WOUT); bf16* WGU = (bf16*)(F.ws + WS_WGU); bf16* WD = (bf16*)(F.ws + WS_WD);
    int r = it;
    if (r < CV_N_IN) { const int l = r / CV_I_IN, i = r % CV_I_IN; return CvDesc{F.w_in + (size_t)l * DM * PROJ_W, WIN + (size_t)l * PROJ_W * DM, DM, PROJ_W, 0, 0, 64 * (i / (PROJ_W / 32)), 32 * (i % (PROJ_W / 32))}; } r -= CV_N_IN;
    if (r < CV_N_OUT) { const int l = r / CV_I_OUT, i = r % CV_I_OUT; return CvDesc{F.w_out + (size_t)l * DM * DM, WOUT + (size_t)l * DM * DM, DM, DM, 0, 0, 64 * (i / (DM / 32)), 32 * (i % (DM / 32))}; } r -= CV_N_OUT;
    if (r < CV_N_G) { const int le = r / CV_I_GU, i = r % CV_I_GU; return CvDesc{F.w_gate + (size_t)le * DM * EFF, WGU + (size_t)le * 2048 * DM, DM, EFF, 0, 1, 64 * (i / (EFF / 32)), 32 * (i % (EFF / 32))}; } r -= CV_N_G;
    if (r < CV_N_G) { const int le = r / CV_I_GU, i = r % CV_I_GU; return CvDesc{F.w_up + (size_t)le * DM * EFF, WGU + (size_t)le * 2048 * DM, DM, EFF, 128, 1, 64 * (i / (EFF / 32)), 32 * (i % (EFF / 32))}; } r -= CV_N_G;
    { const int le = r / CV_I_DN, i = r % CV_I_DN; return CvDesc{F.w_down + (size_t)le * EFF * DM, WD + (size_t)le * DM * EFF, EFF, DM, 0, 0, 64 * (i / (DM / 32)), 32 * (i % (DM / 32))}; }
}
__device__ __forceinline__ void cv_load(const CvDesc& d, f32x4 (&wv)[8], int lane) {
    const float* wp = d.W + (size_t)(d.k0 + (lane >> 3)) * d.N + d.n0 + 4 * (lane & 7);
#pragma unroll
    for (int i = 0; i < 8; ++i) wv[i] = *(const f32x4*)(wp + (size_t)(8 * i) * d.N);
}
__device__ __forceinline__ void cv_finish(const CvDesc& d, const f32x4 (&wv)[8], LAS float* scr, int lane) {
#pragma unroll
    for (int i = 0; i < 8; ++i) { LAS float* w = scr + (8 * i + (lane >> 3)) * 33 + 4 * (lane & 7);
#pragma unroll
        for (int c = 0; c < 4; ++c) w[c] = wv[i][c]; }
    LDS_WAIT(); asm volatile("" ::: "memory");
    const int cch = lane & 7;
#pragma unroll
    for (int j = 0; j < 4; ++j) { const int n = (lane >> 3) + 8 * j; const LAS float* s = scr + (8 * cch) * 33 + n;
        v4u o; o.x = pk2(s[0 * 33], s[1 * 33]); o.y = pk2(s[2 * 33], s[3 * 33]); o.z = pk2(s[4 * 33], s[5 * 33]); o.w = pk2(s[6 * 33], s[7 * 33]);
        const int nn = d.n0 + n; const int drow = d.mode ? (d.row_off + (nn >> 7) * 256 + (nn & 127)) : (d.row_off + nn);
        *(GAS v4u*)(d.WT + (size_t)drow * d.K + d.k0 + 8 * cch) = o; }
    LDS_WAIT(); asm volatile("" ::: "memory");
}
template <class IdFn> __device__ __forceinline__ void convert_stream(Frame& F, int n, IdFn idf) {
    if (n <= 0) return;
    LAS float* scr = (LAS float*)(F.lds + F.wave * 8704);
    f32x4 wa[8], wb[8], wc[8];
    cv_load(cv_desc(F, idf(0)), wa, F.lane);
    if (n > 1) cv_load(cv_desc(F, idf(1)), wb, F.lane);
    for (int k = 0; k < n; k += 3) {
        if (k + 2 < n) cv_load(cv_desc(F, idf(k + 2)), wc, F.lane);
        cv_finish(cv_desc(F, idf(k)), wa, scr, F.lane);
        if (k + 1 < n) { if (k + 3 < n) cv_load(cv_desc(F, idf(k + 3)), wa, F.lane);
            cv_finish(cv_desc(F, idf(k + 1)), wb, scr, F.lane);
            if (k + 2 < n) { if (k + 4 < n) cv_load(cv_desc(F, idf(k + 4)), wb, F.lane);
                cv_finish(cv_desc(F, idf(k + 2)), wc, scr, F.lane); } }
    }
}
__device__ __forceinline__ bool cv_is_deferred(int it) {
    int r = it; if (r < CV_N_IN) return r >= CV_I_IN; r -= CV_N_IN;
    if (r < CV_N_OUT) return r >= CV_I_OUT; r -= CV_N_OUT;
    if (r < CV_N_G) return r >= NEXP * 1024; r -= CV_N_G;
    if (r < CV_N_G) return r >= NEXP * 1024; r -= CV_N_G;
    return r >= NEXP * 1024;
}
__device__ __forceinline__ int cv_deferred_id(int d) {
    const int l = d / (3 * NEXP * 1024), b = d % (3 * NEXP * 1024), t = b / (NEXP * 1024), r = b % (NEXP * 1024);
    return CV_N_IN + CV_N_OUT + t * CV_N_G + l * (NEXP * 1024) + r;
}
__device__ __forceinline__ void deferred_convert(Frame& F, int lo, int hi, int rank, int nidle) {
    const int b0 = lo + rank * NWAVES + F.wave, st = nidle * NWAVES;
    convert_stream(F, b0 < hi ? (hi - b0 + st - 1) / st : 0, [=](int k) { return cv_deferred_id(b0 + k * st); });
}
__device__ __forceinline__ void deferred_inout(Frame& F, int rank, int nidle) {
    const int j0 = rank * NWAVES + F.wave, st = nidle * NWAVES;
    convert_stream(F, j0 < CV_DEFER0 ? (CV_DEFER0 - j0 + st - 1) / st : 0, [=](int k) { const int j = j0 + k * st; return j < CV_I_IN ? CV_I_IN + j : CV_N_IN + CV_I_OUT + (j - CV_I_IN); });
}
__device__ __forceinline__ void p0_prologue(Frame& F) {
    LAS float* sv = (LAS float*)(F.lds + 73728);
    LAS float* red = (LAS float*)(F.lds + 0);
    for (int i = F.tid; i < 3 * DM; i += 512) { const float v = (i < 2 * DM) ? F.c[i] : F.c_ctx[i - 2 * DM]; sv[i] = v / (1.0f + expf(-v)); }
    __syncthreads();
    float* PART = (float*)(F.ws + WS_PART);
    for (int it = blockIdx.x; it < DEPTH * 256; it += F.G) {
        const int l = it >> 8, ks = (it >> 4) & 15, ng = it & 15, k0 = 128 * ks + 16 * F.wave;
        const float* wb = F.w_mod + (size_t)l * DM * 12288 + (size_t)k0 * 12288 + 768 * ng;
        unsigned woff = (unsigned)(16 * F.lane); asm volatile("" : "+v"(woff));
        f32x4 acc[3][3];
#pragma unroll
        for (int r = 0; r < 3; ++r)
#pragma unroll
            for (int q = 0; q < 3; ++q) acc[r][q] = (f32x4){0.f, 0.f, 0.f, 0.f};
#pragma unroll
        for (int hf = 0; hf < 2; ++hf) { f32x4 wv[8][3];
#pragma unroll
            for (int i = 0; i < 8; ++i)
#pragma unroll
                for (int q = 0; q < 3; ++q) wv[i][q] = *(const f32x4*)((const char*)wb + (woff + (unsigned)(((8 * hf + i) * 12288 + 256 * q) * 4)));
#pragma unroll
            for (int i = 0; i < 8; ++i) { const int k = k0 + 8 * hf + i; const float s0 = sv[k], s1 = sv[DM + k], s2 = sv[2 * DM + k];
#pragma unroll
                for (int q = 0; q < 3; ++q) { acc[0][q] += wv[i][q] * s0; acc[1][q] += wv[i][q] * s1; acc[2][q] += wv[i][q] * s2; } } }
#pragma unroll
        for (int r = 0; r < 3; ++r)
#pragma unroll
            for (int q = 0; q < 3; ++q) *(LAS f32x4*)(red + (F.wave * 3 + r) * 768 + 256 * q + 4 * F.lane) = acc[r][q];
        __syncthreads();
        for (int o = F.tid; o < 3 * 192; o += 512) { const int r = o / 192, cidx = 4 * (o % 192); f32x4 sm = {0.f, 0.f, 0.f, 0.f};
#pragma unroll
            for (int w = 0; w < 8; ++w) sm += *(const LAS f32x4*)(red + (w * 3 + r) * 768 + cidx);
            *(f32x4*)(PART + ((size_t)((l * 16 + ks) * 3 + r)) * 12288 + 768 * ng + cidx) = sm; }
        __syncthreads();
    }
    { float* RWT = (float*)(F.ws + WS_RWT);
      for (int i = (int)blockIdx.x * 512 + F.tid; i < DEPTH * DM * NEXP; i += F.G * 512) { const int l = i >> 15, e = (i >> 11) & 15, cc = i & 2047;
          RWT[i] = F.w_router[(size_t)l * DM * NEXP + cc * NEXP + e]; } }
    const int gw = F.vcu * NWAVES + F.wave, NGW = F.G * NWAVES;
    constexpr int NP0 = CV_I_IN + CV_I_OUT + CV_P0E;
    convert_stream(F, gw < NP0 ? (NP0 - gw + NGW - 1) / NGW : 0, [=](int k) { const int q = gw + k * NGW;
        if (q < CV_I_IN) return q;
        if (q < CV_I_IN + CV_I_OUT) return CV_N_IN + (q - CV_I_IN);
        return cv_deferred_id(q - (CV_I_IN + CV_I_OUT)); });
}
__device__ __forceinline__ void store_mod_bf16(bf16* orow, const f32x4 (&v)[8], const float* sh, const float* sc, int lane) {
#pragma unroll
    for (int j = 0; j < 8; ++j) { const int c = 256 * j + 4 * lane; const f32x4 s1 = *(const f32x4*)(sc + c), s0 = *(const f32x4*)(sh + c);
        const f32x4 h = v[j] * (s1 + 1.0f) + s0; v2u w; w.x = pk2(h[0], h[1]); w.y = pk2(h[2], h[3]); *(v2u*)(orow + c) = w; }
}
__device__ __forceinline__ void store_mod_bf16_lds(bf16* orow, const f32x4 (&v)[8], const LAS float* sh, const LAS float* sc1p, int lane) {
#pragma unroll
    for (int j = 0; j < 8; ++j) { const int c = 256 * j + 4 * lane; const f32x4 s1 = *(const LAS f32x4*)(sc1p + c), s0 = *(const LAS f32x4*)(sh + c);
        const f32x4 h = v[j] * s1 + s0; v2u w; w.x = pk2(h[0], h[1]); w.y = pk2(h[2], h[3]); *(v2u*)(orow + c) = w; }
}
__device__ __forceinline__ void p1_modulate(Frame& F) {
    const int gw = F.vcu * NWAVES + F.wave, NGW = F.G * NWAVES;
    float* MOD = (float*)(F.ws + WS_MOD); bf16* XM = (bf16*)(F.ws + WS_XM);
    const float* PART = (const float*)(F.ws + WS_PART);
    for (int o = (int)blockIdx.x * 512 + F.tid; o < DEPTH * 3 * 12288 / 4; o += F.G * 512) { const int l = o / (3 * 3072), rn = o % (3 * 3072), r = rn / 3072, n = 4 * (rn % 3072);
        f32x4 sm = *(const f32x4*)(F.b_mod + (size_t)l * 12288 + n);
#pragma unroll
        for (int ks = 0; ks < 16; ++ks) sm += *(const f32x4*)(PART + ((size_t)((l * 16 + ks) * 3 + r)) * 12288 + n);
        *(f32x4*)(MOD + ((size_t)l * 3 + r) * 12288 + n) = sm; }
    LAS float* PSH = (LAS float*)(F.lds + 0); LAS float* PSC = PSH + 3 * DM;
    for (int i = F.tid; i < 3 * 1024; i += 512) { const int r = i / 1024, col = 4 * (i % 1024);
        f32x4 sm = *(const f32x4*)(F.b_mod + col);
#pragma unroll
        for (int ks = 0; ks < 16; ++ks) sm += *(const f32x4*)(PART + ((size_t)(ks * 3 + r)) * 12288 + col);
        if (col < DM) *(LAS f32x4*)(PSH + r * DM + col) = sm; else *(LAS f32x4*)(PSC + r * DM + (col - DM)) = sm + 1.0f; }
    __syncthreads();
    for (int row = gw; row < MROWS; row += NGW) {
        const int brow = row < NLAT ? (row >> 13) : 2;
        const float* xr = row < NLAT ? F.x + (size_t)row * DM : F.ctx + (size_t)(row - NLAT) * DM;
        f32x4 v[8];
#pragma unroll
        for (int j = 0; j < 8; ++j) v[j] = *(const f32x4*)(xr + 256 * j + 4 * F.lane);
        store_mod_bf16_lds(XM + (size_t)row * DM, v, PSH + brow * DM, PSC + brow * DM, F.lane);
    }
    __syncthreads();
}
__device__ __forceinline__ void ln_inplace(f32x4 (&v)[8], const float* w, const float* b, int lane) {
    float s = 0.f;
#pragma unroll
    for (int j = 0; j < 8; ++j) s += (v[j][0] + v[j][1]) + (v[j][2] + v[j][3]);
    const float mean = wave_sum(s) * (1.0f / DM); float q = 0.f;
#pragma unroll
    for (int j = 0; j < 8; ++j) { v[j] = v[j] - mean; q += (v[j][0] * v[j][0] + v[j][1] * v[j][1]) + (v[j][2] * v[j][2] + v[j][3] * v[j][3]); }
    const float rstd = 1.0f / sqrtf(wave_sum(q) * (1.0f / DM) + LN_EPS);
#pragma unroll
    for (int j = 0; j < 8; ++j) { const int c = 256 * j + 4 * lane; v[j] = v[j] * rstd * *(const f32x4*)(w + c) + *(const f32x4*)(b + c); }
}
__device__ __forceinline__ void ln_norm_only(f32x4 (&v)[8]) {
    float s = 0.f;
#pragma unroll
    for (int j = 0; j < 8; ++j) s += (v[j][0] + v[j][1]) + (v[j][2] + v[j][3]);
    const float mean = wave_sum(s) * (1.0f / DM); float q = 0.f;
#pragma unroll
    for (int j = 0; j < 8; ++j) { v[j] = v[j] - mean; q += (v[j][0] * v[j][0] + v[j][1] * v[j][1]) + (v[j][2] * v[j][2] + v[j][3] * v[j][3]); }
    const float rstd = 1.0f / sqrtf(wave_sum(q) * (1.0f / DM) + LN_EPS);
#pragma unroll
    for (int j = 0; j < 8; ++j) v[j] = v[j] * rstd;
}
__device__ __forceinline__ void ln_inplace_reg(f32x4 (&v)[8], const f32x4 (&w)[8], const f32x4 (&b)[8]) {
    float s = 0.f;
#pragma unroll
    for (int j = 0; j < 8; ++j) s += (v[j][0] + v[j][1]) + (v[j][2] + v[j][3]);
    const float mean = wave_sum(s) * (1.0f / DM); float q = 0.f;
#pragma unroll
    for (int j = 0; j < 8; ++j) { v[j] = v[j] - mean; q += (v[j][0] * v[j][0] + v[j][1] * v[j][1]) + (v[j][2] * v[j][2] + v[j][3] * v[j][3]); }
    const float rstd = 1.0f / sqrtf(wave_sum(q) * (1.0f / DM) + LN_EPS);
#pragma unroll
    for (int j = 0; j < 8; ++j) v[j] = v[j] * rstd * w[j] + b[j];
}
__device__ __forceinline__ void ln_inplace_lds(f32x4 (&v)[8], const LAS float* w, const LAS float* b, int lane) {
    float s = 0.f;
#pragma unroll
    for (int j = 0; j < 8; ++j) s += (v[j][0] + v[j][1]) + (v[j][2] + v[j][3]);
    const float mean = wave_sum(s) * (1.0f / DM); float q = 0.f;
#pragma unroll
    for (int j = 0; j < 8; ++j) { v[j] = v[j] - mean; q += (v[j][0] * v[j][0] + v[j][1] * v[j][1]) + (v[j][2] * v[j][2] + v[j][3] * v[j][3]); }
    const float rstd = 1.0f / sqrtf(wave_sum(q) * (1.0f / DM) + LN_EPS);
#pragma unroll
    for (int j = 0; j < 8; ++j) { const int c = 256 * j + 4 * lane; v[j] = v[j] * rstd * *(const LAS f32x4*)(w + c) + *(const LAS f32x4*)(b + c); }
}
__device__ __forceinline__ void conv_rows(Frame& F, int l, int nrows) {
    const int gw = F.vcu * NWAVES + F.wave, NGW = F.G * NWAVES;
    const bf16* CX = (const bf16*)(F.ws + WS_CG); const bf16* CB = CX + (size_t)MROWS * 512; const bf16* CC = CB + (size_t)MROWS * 512;
    bf16* MIX = (bf16*)(F.ws + WS_MIX);
    const float* wc = F.w_conv + (size_t)l * 3 * CONV_W + 8 * F.lane;
    float w0[8], w1[8], w2[8];
#pragma unroll
    for (int j = 0; j < 8; ++j) { w0[j] = wc[j]; w1[j] = wc[CONV_W + j]; w2[j] = wc[2 * CONV_W + j]; }
    for (int row = gw; row < nrows; row += NGW) {
        const int t = row < NLAT ? (row & (SEQ - 1)) : ((row - NLAT) & (CTXL - 1)); const int tl = row < NLAT ? SEQ - 1 : CTXL - 1;
        const size_t o = (size_t)row * 512 + 8 * F.lane;
        const v4u z4 = {0u, 0u, 0u, 0u};
        const v4u x1 = *(const v4u*)(CX + o), c1 = *(const v4u*)(CC + o), b1 = *(const v4u*)(CB + o);
        const v4u x0 = t > 0 ? *(const v4u*)(CX + o - 512) : z4, c0 = t > 0 ? *(const v4u*)(CC + o - 512) : z4;
        const v4u x2 = t < tl ? *(const v4u*)(CX + o + 512) : z4, c2 = t < tl ? *(const v4u*)(CC + o + 512) : z4;
        v4u ov;
#pragma unroll
        for (int q = 0; q < 4; ++q) {
            const float r0 = (bflo(c0[q]) * bflo(x0[q])) * w0[2 * q] + (bflo(c1[q]) * bflo(x1[q])) * w1[2 * q] + (bflo(c2[q]) * bflo(x2[q])) * w2[2 * q];
            const float r1 = (bfhi(c0[q]) * bfhi(x0[q])) * w0[2 * q + 1] + (bfhi(c1[q]) * bfhi(x1[q])) * w1[2 * q + 1] + (bfhi(c2[q]) * bfhi(x2[q])) * w2[2 * q + 1];
            ov[q] = pk2(bflo(b1[q]) * r0, bfhi(b1[q]) * r1); }
        *(v4u*)(MIX + (size_t)row * DM + ATT_W + 8 * F.lane) = ov;
    }
}
__device__ __forceinline__ void hg_rows(int b, int dir, int c, int& base, int& sgn) {
    if (dir == 0) { sgn = 1; base = (c < 4) ? (NLAT + b * CTXL + c * 64) : (b * SEQ + (c - 4) * 64); }
    else { sgn = -1; base = (c < 4) ? (NLAT + b * CTXL + CTXL - 1 - c * 64) : (b * SEQ + SEQ - 1 - (c - 4) * 64); }
}
__device__ __forceinline__ float hg_lb(const Frame& F, int l, int dir, int ch) {
    if (l == 0) return 0.f;
    const float x0 = F.lb_logits[(dir * DEPTH + 0) * HG_W + ch], x1 = F.lb_logits[(dir * DEPTH + 1) * HG_W + ch];
    return 1.0f / (1.0f + expf(x0 - x1));
}
typedef float f32x4v __attribute__((ext_vector_type(4)));
template <bool WITH_Q> __device__ __forceinline__ void hg_load(const float* zbuf, const bf16* GQ, const bf16* GI, int base, int sgn, int h, int d, int seg,
                                                              float (&z)[16], unsigned (&v)[16], unsigned (&q)[16]) {
    unsigned go = (unsigned)((base + sgn * (seg * 16)) * 512 + h * 128 + d) * 2u;
    asm volatile("" : "+v"(go));
    const unsigned st = (unsigned)(sgn * 1024);
#pragma unroll
    for (int j = 0; j < 16; ++j) { z[j] = *(const float*)((const char*)zbuf + 2u * go); v[j] = *(const bf16*)((const char*)GI + go);
        if (WITH_Q) q[j] = *(const bf16*)((const char*)GQ + go); go += st; }
}
__device__ __forceinline__ void hg_stage1(const float (&zz)[16], int d, int seg, float lb, LAS float* segs, float (&a)[16], float (&kin)[16], float& atot) {
    float run = 0.f;
#pragma unroll
    for (int j = 0; j < 16; ++j) { const float z = fminf(fmaxf(zz[j], -80.f), 80.f);
        const float sg = __builtin_amdgcn_rcpf(1.0f + __expf(-z)); const float f = lb + (1.0f - lb) * sg;
        run += __log2f(f); a[j] = run; kin[j] = (1.0f - lb) * (1.0f - sg); }
    segs[seg * 128 + d] = run;
    LDS_BARRIER();
    float off = 0.f, tot = 0.f;
#pragma unroll
    for (int s = 0; s < 4; ++s) { const float v = segs[s * 128 + d]; if (s < seg) off += v; tot += v; }
#pragma unroll
    for (int j = 0; j < 16; ++j) a[j] += off;
    atot = tot;
}
__device__ __forceinline__ void hg_h1_units(Frame& F, int l) {
    const int d = F.tid & 127, seg = F.tid >> 7, fr = F.lane & 15, fq = F.lane >> 4;
    LAS float* segs = (LAS float*)(F.lds + 0);
    LAS bf16* kdT = (LAS bf16*)(F.lds + 2048);
    LAS bf16* vT = (LAS bf16*)(F.lds + 2048 + 128 * 72 * 2);
    const bf16* GI = (const bf16*)(F.ws + WS_CG) + (size_t)4 * MROWS * 512;
    float z[16]; unsigned vv[16];
    int unit = blockIdx.x;
    if (unit < NSCAN * NCHUNK) { const int sc = unit / NCHUNK, c = unit % NCHUNK; int base, sgn; hg_rows((sc >> 2) & 1, sc >> 3, c, base, sgn);
        hg_load<false>((const float*)(F.ws + WS_GF) + (size_t)(sc >> 3) * MROWS * 512, GI, GI, base, sgn, sc & 3, d, seg, z, vv, vv); }
    for (; unit < NSCAN * NCHUNK; unit += F.G) {
        const int sc = unit / NCHUNK, dir = sc >> 3, h = sc & 3;
        const float lb = hg_lb(F, l, dir, h * 128 + d);
        float a[16], kin[16], atot;
        hg_stage1(z, d, seg, lb, segs, a, kin, atot);
        { v4u kp[2], vp[2];
#pragma unroll
          for (int j = 0; j < 16; j += 2) { const unsigned kw = pk2(kin[j] * __builtin_amdgcn_exp2f(atot - a[j]), kin[j + 1] * __builtin_amdgcn_exp2f(atot - a[j + 1]));
              const unsigned vw = (vv[j] & 0xffffu) | (vv[j + 1] << 16); kp[j >> 3][(j >> 1) & 3] = kw; vp[j >> 3][(j >> 1) & 3] = vw; }
          *(LAS v4u*)(kdT + d * 72 + seg * 16) = kp[0]; *(LAS v4u*)(kdT + d * 72 + seg * 16 + 8) = kp[1];
          *(LAS v4u*)(vT + d * 72 + seg * 16) = vp[0]; *(LAS v4u*)(vT + d * 72 + seg * 16 + 8) = vp[1]; }
        if (seg == 0) ((float*)(F.ws + WS_HD))[(size_t)unit * 128 + d] = __builtin_amdgcn_exp2f(atot);
        LDS_BARRIER();
        { const int un = unit + F.G;
          if (un < NSCAN * NCHUNK) { const int scn = un / NCHUNK, cn = un % NCHUNK; int basen, sgnn; hg_rows((scn >> 2) & 1, scn >> 3, cn, basen, sgnn);
              hg_load<false>((const float*)(F.ws + WS_GF) + (size_t)(scn >> 3) * MROWS * 512, GI, GI, basen, sgnn, scn & 3, d, seg, z, vv, vv); } }
        bf16x8 kf[2];
#pragma unroll
        for (int ks = 0; ks < 2; ++ks) kf[ks] = *(const LAS bf16x8*)(kdT + (F.wave * 16 + fr) * 72 + ks * 32 + fq * 8);
        bf16* UT = (bf16*)(F.ws + WS_HU) + (size_t)unit * 16384;
#pragma unroll
        for (int nt = 0; nt < 8; ++nt) { f32x4v acc = {0.f, 0.f, 0.f, 0.f};
#pragma unroll
            for (int ks = 0; ks < 2; ++ks) { const bf16x8 vf = *(const LAS bf16x8*)(vT + (nt * 16 + fr) * 72 + ks * 32 + fq * 8);
                acc = __builtin_amdgcn_mfma_f32_16x16x32_bf16(kf[ks], vf, acc, 0, 0, 0); }
            { v2u w; w.x = pk2(acc[0], acc[1]); w.y = pk2(acc[2], acc[3]); *(v2u*)(UT + (size_t)(nt * 16 + fr) * 128 + F.wave * 16 + fq * 4) = w; } }
        LDS_BARRIER();
    }
}
__device__ __forceinline__ void hg_h2(Frame& F) {
    const bf16* UT = (const bf16*)(F.ws + WS_HU); const float* HD = (const float*)(F.ws + WS_HD); bf16* HS = (bf16*)(F.ws + WS_HS);
    if (F.tid < 256) for (int e = (int)blockIdx.x * 256 + F.tid; e < NSCAN * 4096; e += F.G * 256) {
        const int sc = e >> 12, idx = (e & 4095) * 4, dk = idx & 127;
        const bf16* up = UT + (size_t)sc * NCHUNK * 16384 + idx; const float* dp = HD + (size_t)sc * NCHUNK * 128 + dk; bf16* sp = HS + (size_t)sc * NCHUNK * 16384 + idx;
        f32x4 S = {0.f, 0.f, 0.f, 0.f};
        for (int c0 = 0; c0 < NCHUNK; c0 += 12) {
            v2u u[12]; f32x4 dd[12];
#pragma unroll
            for (int k = 0; k < 12; ++k) { u[k] = *(const v2u*)(up + (size_t)(c0 + k) * 16384); dd[k] = *(const f32x4*)(dp + (c0 + k) * 128); }
#pragma unroll
            for (int k = 0; k < 12; ++k) { v2u w; w.x = pk2(S[0], S[1]); w.y = pk2(S[2], S[3]); *(v2u*)(sp + (size_t)(c0 + k) * 16384) = w;
                const f32x4 uf = {bflo(u[k].x), bfhi(u[k].x), bflo(u[k].y), bfhi(u[k].y)}; S = dd[k] * S + uf; }
        }
    }
}
#ifndef MK_HSEL
#define MK_HSEL (-1)
#endif
#define H3SEG(k) do { if (MK_HSEL >= 0 && blockIdx.x == 0 && threadIdx.x == 0) { volatile LAS unsigned* hs_ = (volatile LAS unsigned*)(F.lds + RING_BYTES + 128); const unsigned tn_ = (unsigned)__builtin_amdgcn_s_memrealtime(); if (MK_HSEL == (k)) hs_[0] += tn_ - hs_[1]; hs_[1] = tn_; } } while (0)
__device__ __forceinline__ void hg_h3_unit(Frame& F, int l, int unit) {
    const int bh = unit / NCHUNK, oc = unit % NCHUNK, b = bh >> 2, h = bh & 3;
    int t_l = F.tid; asm volatile("" : "+v"(t_l));
    const int d = t_l & 127, seg = __builtin_amdgcn_readfirstlane(t_l >> 7), fr = t_l & 15, fq = (t_l >> 4) & 3;
    LAS bf16* QT = (LAS bf16*)(F.lds + 0);
    LAS bf16* KT = (LAS bf16*)(F.lds + 17408);
    LAS bf16* vT = (LAS bf16*)(F.lds + 60928);
    LAS bf16* scS = (LAS bf16*)(F.lds + 79360);
    LAS float* OS = (LAS float*)(F.lds + 88576);
    LAS float* erho = (LAS float*)(F.lds + 121344);
    LAS float* segs = (LAS float*)(F.lds + 123392);
    const bf16* GQ = (const bf16*)(F.ws + WS_CG) + (size_t)3 * MROWS * 512; const bf16* GI = GQ + (size_t)MROWS * 512; const bf16* GG = GI + (size_t)MROWS * 512;
    float zin[16]; unsigned vin[16], qin[16];
    { int base, sgn; hg_rows(b, 0, oc, base, sgn); hg_load<true>((const float*)(F.ws + WS_GF), GQ, GI, base, sgn, h, d, seg, zin, vin, qin); }
    H3SEG(9);
    int base0, sg0; hg_rows(b, 0, oc, base0, sg0);
    const float lb_d0 = hg_lb(F, l, 0, h * 128 + d), lb_d1 = hg_lb(F, l, 1, h * 128 + d);
    unsigned gin0[8], gin1[8];
    for (int dir = 0; dir < 2; ++dir) {
        const int c = dir == 0 ? oc : (oc < 4 ? 3 - oc : 135 - oc);
        const int sc = dir * 8 + b * 4 + h;
        const float lb = dir == 0 ? lb_d0 : lb_d1;
        {
          float loc[16], kin[16]; float run = 0.f;
#pragma unroll
          for (int j = 0; j < 16; ++j) { const float z = fminf(fmaxf(zin[j], -80.f), 80.f);
              const float sg = __builtin_amdgcn_rcpf(1.0f + __expf(-z)); const float f = lb + (1.0f - lb) * sg;
              run += __log2f(f); loc[j] = run; kin[j] = (1.0f - lb) * (1.0f - sg); }
          segs[seg * 128 + d] = run;
          LDS_BARRIER(); H3SEG(4);
          float st[4];
#pragma unroll
          for (int q = 0; q < 4; ++q) st[q] = segs[q * 128 + d];
          float off = 0.f;
#pragma unroll
          for (int q = 0; q < 4; ++q) if (q < seg) off += st[q];
          erho[seg * 128 + d] = __builtin_amdgcn_exp2f(off);
#pragma unroll
          for (int j = 0; j < 16; ++j) QT[(seg * 16 + j) * 136 + d] = (bf16)f2bf(bflo(qin[j]) * __builtin_amdgcn_exp2f(loc[j]));
          float delta = 0.f;
#pragma unroll
          for (int I = 0; I < 4; ++I) { if (I >= seg) { LAS bf16* kp = KT + ((I * (I + 1) / 2 + seg) * 16) * 136 + d;
#pragma unroll
                  for (int j = 0; j < 16; ++j) kp[j * 136] = (bf16)f2bf(kin[j] * __builtin_amdgcn_exp2f(fminf(delta - loc[j], 80.f)));
                  delta += st[I]; } }
          v4u vp[2];
#pragma unroll
          for (int j = 0; j < 16; j += 2) vp[j >> 3][(j >> 1) & 3] = (vin[j] & 0xffffu) | (vin[j + 1] << 16);
          *(LAS v4u*)(vT + d * 72 + seg * 16) = vp[0]; *(LAS v4u*)(vT + d * 72 + seg * 16 + 8) = vp[1]; }
        const bf16* Sst = (const bf16*)(F.ws + WS_HS) + ((size_t)sc * NCHUNK + c) * 16384;
        bf16x8 sfr[4][4];
#pragma unroll
        for (int q4 = 0; q4 < 4; ++q4)
#pragma unroll
            for (int ks = 0; ks < 4; ++ks) sfr[q4][ks] = *(const bf16x8*)((const char*)Sst + (unsigned)((((F.wave >> 2) * 64 + fr) * 128 + fq * 8) * 2) + (unsigned)(q4 * 4096 + ks * 64));
        for (int i = F.tid; i < 64 * 72 / 2; i += 512) ((LAS unsigned*)scS)[i] = 0u;
        LDS_BARRIER(); H3SEG(0);
        for (int blk = F.wave; blk < 10; blk += 8) {
            const int I = blk < 1 ? 0 : (blk < 3 ? 1 : (blk < 6 ? 2 : 3)); const int J = blk - (I * (I + 1)) / 2;
            f32x4v acc = {0.f, 0.f, 0.f, 0.f};
#pragma unroll
            for (int ks = 0; ks < 4; ++ks) { const int dk0 = 32 * ks + 8 * fq;
                const bf16x8 af = *(const LAS bf16x8*)(QT + (16 * I + fr) * 136 + dk0), bfr = *(const LAS bf16x8*)(KT + (blk * 16 + fr) * 136 + dk0);
                acc = __builtin_amdgcn_mfma_f32_16x16x32_bf16(af, bfr, acc, 0, 0, 0); }
#pragma unroll
            for (int r = 0; r < 4; ++r) { const int ii = 16 * I + 4 * fq + r, jj = 16 * J + fr; const float v = (jj <= ii) ? acc[r] : 0.f; scS[ii * 72 + jj] = (bf16)f2bf(v); }
        }
        LDS_BARRIER(); H3SEG(1);
        if (dir == 0) { const int c1 = oc < 4 ? 3 - oc : 135 - oc; int base1, sgn1; hg_rows(b, 1, c1, base1, sgn1);
            hg_load<true>((const float*)(F.ws + WS_GF) + (size_t)MROWS * 512, GQ, GI, base1, sgn1, h, d, seg, zin, vin, qin); }
        else {
#pragma unroll
            for (int tt = 0; tt < 8; ++tt) { const unsigned go = (unsigned)(((base0 + F.wave * 8 + tt) * 512 + h * 128 + (t_l & 63)) * 2);
                gin0[tt] = *(const bf16*)((const char*)GG + go); gin1[tt] = *(const bf16*)((const char*)GG + go + 128); } }
        { const int mt = F.wave & 3, ti = 16 * mt + fr;
          bf16x8 sa[2], qa[4];
#pragma unroll
          for (int ks = 0; ks < 2; ++ks) sa[ks] = *(const LAS bf16x8*)(scS + ti * 72 + ks * 32 + fq * 8);
#pragma unroll
          for (int ks = 0; ks < 4; ++ks) { const int dk0 = 32 * ks + 8 * fq; const bf16x8 qv = *(const LAS bf16x8*)(QT + ti * 136 + dk0);
              const f32x4 e0 = *(const LAS f32x4*)(erho + mt * 128 + dk0), e1 = *(const LAS f32x4*)(erho + mt * 128 + dk0 + 4);
#pragma unroll
              for (int jj = 0; jj < 8; jj += 2) { const float x0 = bf2f((unsigned short)qv[jj]) * (jj < 4 ? e0[jj & 3] : e1[jj & 3]), x1 = bf2f((unsigned short)qv[jj + 1]) * (jj < 4 ? e0[(jj & 3) + 1] : e1[(jj & 3) + 1]);
                  const unsigned pq = pg8::cvt_pk_bf16(x0, x1);
                  qa[ks][jj] = (short)(pq & 0xffffu); qa[ks][jj + 1] = (short)(pq >> 16); } }
#pragma unroll
          for (int q4 = 0; q4 < 4; ++q4) { const int nt = (F.wave >> 2) * 4 + q4; f32x4v acc = {0.f, 0.f, 0.f, 0.f};
#pragma unroll
              for (int ks = 0; ks < 2; ++ks) { const bf16x8 vf = *(const LAS bf16x8*)(vT + (nt * 16 + fr) * 72 + ks * 32 + fq * 8);
                  acc = __builtin_amdgcn_mfma_f32_16x16x32_bf16(sa[ks], vf, acc, 0, 0, 0); }
#pragma unroll
              for (int ks = 0; ks < 4; ++ks) acc = __builtin_amdgcn_mfma_f32_16x16x32_bf16(qa[ks], sfr[q4][ks], acc, 0, 0, 0);
#pragma unroll
              for (int r = 0; r < 4; ++r) { const int is = 16 * mt + 4 * fq + r; const int ot = dir == 0 ? is : 63 - is; LAS float* op = OS + ot * 128 + nt * 16 + fr;
                  if (dir == 0) *op = acc[r]; else *op += acc[r]; } } }
        LDS_BARRIER(); H3SEG(2);
    }
    { const int ln = t_l & 63;
      const float nw0 = F.hgrn_norm_w[l * 128 + ln], nw1 = F.hgrn_norm_w[l * 128 + 64 + ln];
      bf16* MIX = (bf16*)(F.ws + WS_MIX);
      float v0[8], v1[8], ss[8];
#pragma unroll
      for (int tt = 0; tt < 8; ++tt) { const int t = F.wave * 8 + tt; v0[tt] = OS[t * 128 + ln]; v1[tt] = OS[t * 128 + 64 + ln]; ss[tt] = v0[tt] * v0[tt] + v1[tt] * v1[tt]; }
#pragma unroll
      for (int o = 1; o < 64; o <<= 1)
#pragma unroll
          for (int tt = 0; tt < 8; ++tt) ss[tt] += __shfl_xor(ss[tt], o);
#pragma unroll
      for (int tt = 0; tt < 8; ++tt) { const int t = F.wave * 8 + tt; const float rs = 1.0f / sqrtf(ss[tt] * (1.0f / 128.0f) + LN_EPS);
          const size_t row = (size_t)(base0 + t); const float g0 = bflo(gin0[tt]), g1 = bflo(gin1[tt]);
          bf16* mp = MIX + row * DM + ATT_W + CONV_W + h * 128;
          mp[ln] = (bf16)f2bf(v0[tt] * rs * nw0 * (g0 * __builtin_amdgcn_rcpf(1.0f + __expf(-g0)))); mp[64 + ln] = (bf16)f2bf(v1[tt] * rs * nw1 * (g1 * __builtin_amdgcn_rcpf(1.0f + __expf(-g1)))); } }
    LDS_BARRIER(); H3SEG(3);
}
__device__ __forceinline__ float router_softmax(float mine) {
    float mx = mine;
    mx = fmaxf(mx, __shfl_xor(mx, 1)); mx = fmaxf(mx, __shfl_xor(mx, 2)); mx = fmaxf(mx, __shfl_xor(mx, 4)); mx = fmaxf(mx, __shfl_xor(mx, 8));
    const float ex = expf(mine - mx);
    float den = ex;
    den += __shfl_xor(den, 1); den += __shfl_xor(den, 2); den += __shfl_xor(den, 4); den += __shfl_xor(den, 8);
    return ex / den;
}
__device__ __forceinline__ void router_store(Frame& F, float affv, int row, bool doit) {
    float* AFF = (float*)(F.ws + WS_AFF); float* AFFC = (float*)(F.ws + WS_AFFC);
    if (F.lane < 16 && doit) { if (row < NLAT) AFF[((size_t)(row >> 13) * NEXP + F.lane) * SEQ + (row & (SEQ - 1))] = affv;
                       else { const int rc = row - NLAT; AFFC[((size_t)(rc >> 8) * NEXP + F.lane) * CTXL + (rc & (CTXL - 1))] = affv; } }
}
__device__ __forceinline__ void ln1_router(Frame& F, int l, int nrows) {
    LAS float* RW = (LAS float*)(F.lds + 0);
    { const float* rwt = (const float*)(F.ws + WS_RWT) + (size_t)l * DM * NEXP; f32x4 wv[16];
#pragma unroll
      for (int k = 0; k < 16; ++k) wv[k] = *(const f32x4*)(rwt + 4 * (F.tid + 512 * k));
#pragma unroll
      for (int k = 0; k < 16; ++k) *(LAS f32x4*)(RW + 4 * (F.tid + 512 * k)) = wv[k]; }
    __syncthreads();
    const int gw = F.vcu * NWAVES + F.wave, NGW = F.G * NWAVES;
    const float* MOD = (const float*)(F.ws + WS_MOD) + (size_t)l * 3 * 12288;
    bf16* XM = (bf16*)(F.ws + WS_XM);
    const float* lw = F.ln_w + (size_t)(l * 2 + 0) * DM; const float* lbp = F.ln_b + (size_t)(l * 2 + 0) * DM;
    LAS float* PBS = (LAS float*)(F.lds + SPARE_OFF); LAS float* PWS = PBS + DM;
    int staged = -1;
    float paff0 = 0.f, paff1 = 0.f;
    f32x4 nv[2][8];
#define LN1_FETCH(r0_) do { const int ra_ = (r0_), rb_ = (ra_ + NGW < nrows) ? ra_ + NGW : ra_; \
        const float* za_ = (const float*)(F.ws + WS_Z) + (size_t)ra_ * DM; const float* zb_ = (const float*)(F.ws + WS_Z) + (size_t)rb_ * DM; \
        _Pragma("unroll") for (int j = 0; j < 8; ++j) { nv[0][j] = *(const f32x4*)(za_ + 256 * j + 4 * F.lane); nv[1][j] = *(const f32x4*)(zb_ + 256 * j + 4 * F.lane); } } while (0)
    const int ntrip = (nrows + 2 * NGW - 1) / (2 * NGW);
    if (gw < nrows) LN1_FETCH(gw);
    for (int t = 0; t < ntrip; ++t) {
        const int band_row = 2 * t * NGW; const int band = band_row < NLAT ? (band_row >> 13) : 2;
        if (band != staged) {
            LDS_BARRIER();
            const float* sh2 = MOD + (size_t)band * 12288 + 3 * DM; const float* sc2 = sh2 + DM;
            for (int i = F.tid; i < DM / 4; i += 512) { const f32x4 s1 = *(const f32x4*)(sc2 + 4 * i) + 1.0f;
                *(LAS f32x4*)(PWS + 4 * i) = *(const f32x4*)(lw + 4 * i) * s1; *(LAS f32x4*)(PBS + 4 * i) = *(const f32x4*)(lbp + 4 * i) * s1 + *(const f32x4*)(sh2 + 4 * i); }
            asm volatile("s_waitcnt vmcnt(0)" ::: "memory"); LDS_BARRIER(); staged = band; }
        const int row0 = gw + 2 * t * NGW;
        if (row0 < nrows) {
        const bool has1 = row0 + NGW < nrows; const int rows[2] = {row0, has1 ? row0 + NGW : row0};
        f32x4 v[2][8];
#pragma unroll
        for (int q = 0; q < 2; ++q)
#pragma unroll
            for (int j = 0; j < 8; ++j) v[q][j] = nv[q][j];
        if (row0 + 2 * NGW < nrows) LN1_FETCH(row0 + 2 * NGW);
        if (t > 0) { const int pr = row0 - 2 * NGW; router_store(F, paff0, pr, true); router_store(F, paff1, pr + NGW, true); }
#pragma unroll
        for (int q = 0; q < 2; ++q) { const int row = rows[q];
            ln_norm_only(v[q]);
#pragma unroll
            for (int j = 0; j < 8; ++j) { const int cc = 256 * j + 4 * F.lane; v[q][j] = v[q][j] * *(const LAS f32x4*)(PWS + cc) + *(const LAS f32x4*)(PBS + cc); }
            if (q == 0 || has1) { bf16* xo = XM + (size_t)row * DM;
#pragma unroll
                for (int j = 0; j < 8; ++j) { v2u w; w.x = pk2(v[q][j][0], v[q][j][1]); w.y = pk2(v[q][j][2], v[q][j][3]); *(v2u*)(xo + 256 * j + 4 * F.lane) = w; } }
            asm volatile("" ::: "memory"); }
        float mine0 = 0.f, mine1 = 0.f;
#pragma unroll 1
        for (int g = 0; g < 4; ++g) {
            float a0[4], a1[4];
#pragma unroll
            for (int k = 0; k < 4; ++k) { float x0 = 0.f, x1 = 0.f; const LAS float* wp = RW + (4 * g + k) * DM + 4 * F.lane;
#pragma unroll
                for (int j = 0; j < 8; ++j) { const f32x4 w4 = *(const LAS f32x4*)(wp + 256 * j);
                    x0 += (v[0][j][0] * w4[0] + v[0][j][1] * w4[1]) + (v[0][j][2] * w4[2] + v[0][j][3] * w4[3]);
                    x1 += (v[1][j][0] * w4[0] + v[1][j][1] * w4[1]) + (v[1][j][2] * w4[2] + v[1][j][3] * w4[3]); }
                a0[k] = x0; a1[k] = x1; }
            const bool u0 = F.lane & 1, u1 = (F.lane >> 1) & 1;
            float b00 = (u0 ? a0[1] : a0[0]) + __shfl_xor(u0 ? a0[0] : a0[1], 1), b01 = (u0 ? a0[3] : a0[2]) + __shfl_xor(u0 ? a0[2] : a0[3], 1);
            float b10 = (u0 ? a1[1] : a1[0]) + __shfl_xor(u0 ? a1[0] : a1[1], 1), b11 = (u0 ? a1[3] : a1[2]) + __shfl_xor(u0 ? a1[2] : a1[3], 1);
            float c0 = (u1 ? b01 : b00) + __shfl_xor(u1 ? b00 : b01, 2), c1 = (u1 ? b11 : b10) + __shfl_xor(u1 ? b10 : b11, 2);
#pragma unroll
            for (int o = 4; o < 64; o <<= 1) { c0 += __shfl_xor(c0, o); c1 += __shfl_xor(c1, o); }
            const bool sel = ((F.lane >> 2) & 3) == g; mine0 = sel ? c0 : mine0; mine1 = sel ? c1 : mine1;
        }
        paff0 = router_softmax(mine0); paff1 = router_softmax(mine1);
        if (row0 + 2 * NGW >= nrows) { router_store(F, paff0, rows[0], true); router_store(F, paff1, rows[1], has1); }
        }
    }
#undef LN1_FETCH
    __syncthreads();
}
__device__ __forceinline__ void topk_unit(Frame& F, int unit) {
    const bool isc = unit >= 32; const int be = isc ? unit - 32 : unit, b = be >> 4, e = be & 15;
    const int N = isc ? CTXL : SEQ, cap = isc ? CAPC : CAP;
    const float* aff = isc ? (const float*)(F.ws + WS_AFFC) + (size_t)be * CTXL : (const float*)(F.ws + WS_AFF) + (size_t)be * SEQ;
    int* IDX = isc ? (int*)(F.ws + WS_IDXC) + be * CAPC : (int*)(F.ws + WS_IDX) + be * CAP;
    float* GATE = isc ? (float*)(F.ws + WS_GATEC) + be * CAPC : (float*)(F.ws + WS_GATE) + be * CAP;
    int* INV = (int*)(F.ws + WS_INV) + (size_t)(isc ? NLAT + b * CTXL : b * SEQ) * 16 + e;
    int* ROWSRC = (int*)(F.ws + WS_ROWSRC) + (isc ? XG_LAT_ROWS + e * 256 + b * 32 : e * 2048 + b * 1024); const int rsrc0 = isc ? NLAT + b * CTXL : b * SEQ;
    LAS unsigned* hist = (LAS unsigned*)(F.lds + 0);
    LAS unsigned* ctl = (LAS unsigned*)(F.lds + 1024);
    LAS unsigned* wtot = (LAS unsigned*)(F.lds + 2048);
    unsigned key[16];
#pragma unroll
    for (int j = 0; j < 16; ++j) { const int n = F.tid * 16 + j; key[j] = n < N ? __float_as_uint(aff[n < N ? n : 0]) : 0u; }
    if (F.tid == 0) { ctl[0] = 0u; ctl[1] = (unsigned)cap; }
    for (int pass = 0; pass < 4; ++pass) {
        const int shift = 24 - 8 * pass;
        if (F.tid < 256) hist[F.tid] = 0u;
        __syncthreads();
        const unsigned prefix = ctl[0]; const unsigned himask = pass == 0 ? 0u : (0xffffffffu << (shift + 8));
#pragma unroll
        for (int j = 0; j < 16; ++j) { const int n = F.tid * 16 + j; if (n < N && (key[j] & himask) == prefix) atomicAdd((unsigned*)&hist[(key[j] >> shift) & 255u], 1u); }
        __syncthreads();
        if (F.wave == 0) {
            const unsigned need = ctl[1];
            const unsigned h0 = hist[4 * F.lane], h1 = hist[4 * F.lane + 1], h2 = hist[4 * F.lane + 2], h3 = hist[4 * F.lane + 3];
            const unsigned mysum = h0 + h1 + h2 + h3;
            unsigned suf = mysum;
#pragma unroll
            for (int o = 1; o < 64; o <<= 1) { const unsigned t = __shfl_down(suf, o); if (F.lane + o < 64) suf += t; }
            const unsigned above = suf - mysum;
            if (above < need && need <= suf) { unsigned cum = above; int bin;
                if (cum + h3 >= need) bin = 3; else { cum += h3; if (cum + h2 >= need) bin = 2; else { cum += h2; if (cum + h1 >= need) bin = 1; else { cum += h1; bin = 0; } } }
                ctl[0] = prefix | ((unsigned)(4 * F.lane + bin) << shift); ctl[1] = need - cum; }
        }
        __syncthreads();
    }
    const unsigned T = ctl[0], need = ctl[1];
    unsigned cnt = 0u;
#pragma unroll
    for (int j = 0; j < 16; ++j) { const int n = F.tid * 16 + j; if (n < N) cnt += (key[j] > T ? 0x10000u : 0u) + (key[j] == T ? 1u : 0u); }
    unsigned inc = cnt;
#pragma unroll
    for (int o = 1; o < 64; o <<= 1) { const unsigned t = __shfl_up(inc, o); if (F.lane >= o) inc += t; }
    if (F.lane == 63) wtot[F.wave] = inc;
    __syncthreads();
    unsigned woff = 0u, total = 0u;
#pragma unroll
    for (int w = 0; w < 8; ++w) { const unsigned t = wtot[w]; if (w < F.wave) woff += t; total += t; }
    unsigned excl = woff + inc - cnt;
    const unsigned ngt = total >> 16;
    unsigned g_before = excl >> 16, e_before = excl & 0xffffu;
#pragma unroll
    for (int j = 0; j < 16; ++j) { const int n = F.tid * 16 + j; if (n < N) {
        int slot = -1;
        if (key[j] > T) { slot = (int)g_before; ++g_before; }
        else if (key[j] == T) { if (e_before < need) slot = (int)(ngt + e_before); ++e_before; }
        INV[(size_t)n * 16] = slot;
        if (slot >= 0) { IDX[slot] = n; GATE[slot] = __uint_as_float(key[j]); ROWSRC[slot] = rsrc0 + n; } } }
    if (isc && b == 0 && F.tid < 192) ((int*)(F.ws + WS_ROWSRC))[XG_LAT_ROWS + e * 256 + 64 + F.tid] = NLAT;
    __syncthreads();
}
__device__ __forceinline__ void gather_rows(Frame& F, int l) {
    const int gw = F.vcu * NWAVES + F.wave, NGW = F.G * NWAVES;
    const bf16* XM = (const bf16*)(F.ws + WS_XM); bf16* XG = (bf16*)(F.ws + WS_XG);
    const int* IDX = (const int*)(F.ws + WS_IDX); const int* IDXC = (const int*)(F.ws + WS_IDXC);
    const int ntot = XG_LAT_ROWS + (l == 0 ? NEXP * 64 : 0);
    for (int r = gw; r < ntot; r += NGW) {
        size_t src, dst;
        if (r < XG_LAT_ROWS) { const int e = r >> 11, b = (r >> 10) & 1, slot = r & 1023; src = (size_t)(b * SEQ + IDX[(b * NEXP + e) * CAP + slot]); dst = (size_t)r; }
        else { const int rc = r - XG_LAT_ROWS, e = rc >> 6, b = (rc >> 5) & 1, slot = rc & 31; src = (size_t)(NLAT + b * CTXL + IDXC[(b * NEXP + e) * CAPC + slot]); dst = (size_t)(XG_LAT_ROWS + e * 256 + b * 32 + slot); }
        const v4u* sp = (const v4u*)(XM + src * DM) + F.lane; v4u* dp = (v4u*)(XG + dst * DM) + F.lane;
        v4u t0 = sp[0], t1 = sp[64], t2 = sp[128], t3 = sp[192];
        dp[0] = t0; dp[64] = t1; dp[128] = t2; dp[192] = t3;
    }
}
__device__ __forceinline__ void combine_ln2(Frame& F, int l, int nrows) {
    const int gw = F.vcu * NWAVES + F.wave, NGW = F.G * NWAVES;
    const float* MODL = (const float*)(F.ws + WS_MOD) + (size_t)l * 3 * 12288;
    const float* R1 = (const float*)(F.ws + WS_Z); const bf16* Y = (const bf16*)(F.ws + WS_Y);
    const int* INV = (const int*)(F.ws + WS_INV);
    const float* GATE = (const float*)(F.ws + WS_GATE); const float* GATEC = (const float*)(F.ws + WS_GATEC);
    LAS float* PG2 = (LAS float*)(F.lds + 0); LAS float* PLW = PG2 + 3 * DM; LAS float* PLB = PLW + DM; LAS float* PSH = PLB + DM; LAS float* PSC = PSH + 3 * DM;
    LAS float* PLW1 = PSC + 3 * DM; LAS float* PLB1 = PLW1 + DM;
    { const float* lw = F.ln_w + (size_t)(l * 2 + 1) * DM; const float* lbp = F.ln_b + (size_t)(l * 2 + 1) * DM;
      const float* MN = (const float*)(F.ws + WS_MOD) + (size_t)((l + 1 < DEPTH) ? l + 1 : l) * 3 * 12288;
      for (int i = F.tid; i < DM / 4; i += 512) { const int c = 4 * i;
          *(LAS f32x4*)(PLW + c) = *(const f32x4*)(lw + c); *(LAS f32x4*)(PLB + c) = *(const f32x4*)(lbp + c);
          *(LAS f32x4*)(PLW1 + c) = *(const f32x4*)(F.ln_w + (size_t)(l * 2 + 0) * DM + c); *(LAS f32x4*)(PLB1 + c) = *(const f32x4*)(F.ln_b + (size_t)(l * 2 + 0) * DM + c);
#pragma unroll
          for (int r = 0; r < 3; ++r) { *(LAS f32x4*)(PG2 + r * DM + c) = *(const f32x4*)(MODL + (size_t)r * 12288 + 5 * DM + c);
              *(LAS f32x4*)(PSH + r * DM + c) = *(const f32x4*)(MN + (size_t)r * 12288 + c); *(LAS f32x4*)(PSC + r * DM + c) = *(const f32x4*)(MN + (size_t)r * 12288 + DM + c) + 1.0f; } }
      __syncthreads(); }
    const int le = F.lane & 15;
    int nslot = -1; float ngate = 0.f; f32x4 nx[8];
#define CB_FETCH(r_) do { const int r__ = (r_); const bool lat__ = r__ < NLAT; const int b__ = lat__ ? (r__ >> 13) : ((r__ - NLAT) >> 8); \
        nslot = INV[(size_t)r__ * 16 + le]; \
        ngate = nslot >= 0 ? (lat__ ? GATE[(b__ * NEXP + le) * CAP + nslot] : GATEC[(b__ * NEXP + le) * CAPC + nslot]) : 0.f; \
        const float* xr__ = R1 + (size_t)r__ * DM; _Pragma("unroll") for (int j = 0; j < 8; ++j) nx[j] = *(const f32x4*)(xr__ + 256 * j + 4 * F.lane); } while (0)
    if (gw < nrows) CB_FETCH(gw);
    for (int row = gw; row < nrows; row += NGW) {
        const bool lat = row < NLAT; const int brow = lat ? (row >> 13) : 2; const int b = lat ? (row >> 13) : ((row - NLAT) >> 8);
        f32x4 moe[8];
#pragma unroll
        for (int j = 0; j < 8; ++j) moe[j] = (f32x4){0.f, 0.f, 0.f, 0.f};
        const int myslot = nslot; const float mygate = ngate; f32x4 xcur[8];
#pragma unroll
        for (int j = 0; j < 8; ++j) xcur[j] = nx[j];
        if (row + NGW < nrows) CB_FETCH(row + NGW);
        unsigned long long mask = __ballot(myslot >= 0 && F.lane < 16);
        while (mask) {
            const int e0 = __builtin_ctzll(mask); mask &= mask - 1;
            const bool two = mask != 0; const int e1 = two ? __builtin_ctzll(mask) : e0; if (two) mask &= mask - 1;
            const int s0 = __shfl(myslot, e0), s1 = __shfl(myslot, e1);
            const float g0 = __shfl(mygate, e0), g1 = two ? __shfl(mygate, e1) : 0.f;
            const size_t yr0 = lat ? (size_t)(e0 * 2048 + b * 1024 + s0) : (size_t)(XG_LAT_ROWS + e0 * 256 + b * 32 + s0);
            const size_t yr1 = lat ? (size_t)(e1 * 2048 + b * 1024 + s1) : (size_t)(XG_LAT_ROWS + e1 * 256 + b * 32 + s1);
            const bf16* yp0 = Y + yr0 * DM + 4 * F.lane; const bf16* yp1 = Y + yr1 * DM + 4 * F.lane;
            v2u w0[8], w1[8];
#pragma unroll
            for (int j = 0; j < 8; ++j) { w0[j] = *(const v2u*)(yp0 + 256 * j); w1[j] = *(const v2u*)(yp1 + 256 * j); }
#pragma unroll
            for (int j = 0; j < 8; ++j) {
                moe[j][0] += g0 * bflo(w0[j].x); moe[j][1] += g0 * bfhi(w0[j].x); moe[j][2] += g0 * bflo(w0[j].y); moe[j][3] += g0 * bfhi(w0[j].y);
                moe[j][0] += g1 * bflo(w1[j].x); moe[j][1] += g1 * bfhi(w1[j].x); moe[j][2] += g1 * bflo(w1[j].y); moe[j][3] += g1 * bfhi(w1[j].y); }
        }
        const LAS float* g2 = PG2 + brow * DM;
        asm volatile("" ::: "memory");
        ln_norm_only(xcur);
        asm volatile("" ::: "memory");
#pragma unroll
        for (int j = 0; j < 8; ++j) { const int cc = 256 * j + 4 * F.lane;
            xcur[j] = (xcur[j] * *(const LAS f32x4*)(PLW1 + cc) + *(const LAS f32x4*)(PLB1 + cc)) * ALPHA_RES + *(const LAS f32x4*)(g2 + cc) * moe[j]; }
        asm volatile("" ::: "memory");
        ln_inplace_lds(xcur, PLW, PLB, F.lane);
        float* orow = lat ? F.out + (size_t)row * DM : (float*)(F.ws + WS_R2C) + (size_t)(row - NLAT) * DM;
#pragma unroll
        for (int j = 0; j < 8; ++j) *(f32x4*)(orow + 256 * j + 4 * F.lane) = xcur[j];
        if (l + 1 < DEPTH) store_mod_bf16_lds((bf16*)(F.ws + WS_XM) + (size_t)row * DM, xcur, PSH + brow * DM, PSC + brow * DM, F.lane);
    }
#undef CB_FETCH
    __syncthreads();
}

#ifndef MK_ONE_LAUNCH
#define MK_ONE_LAUNCH 1
#endif
constexpr int NPHASE = 2 + 11 * DEPTH;
struct Args { const float* in[19]; float* out; unsigned char* ws; int ph_lo, ph_hi; };
__global__ void __launch_bounds__(NWAVES * 64, 2) mk_fwd(Args args) {
    extern __shared__ __attribute__((aligned(16))) unsigned char lds[];
    Frame F;
    F.lds = (LAS unsigned char*)lds; F.ldsg = (char*)lds;
    F.tid = threadIdx.x; F.lane = F.tid & 63; F.wave = __builtin_amdgcn_readfirstlane(F.tid >> 6);
    F.G = gridDim.x; { const int bx = blockIdx.x; F.vcu = (F.G % 8 == 0) ? (bx % 8) * (F.G / 8) + bx / 8 : bx; }
    F.ws = args.ws; F.out = args.out;
    F.x = args.in[0]; F.c = args.in[1]; F.ctx = args.in[2]; F.c_ctx = args.in[3]; F.w_mod = args.in[4]; F.b_mod = args.in[5]; F.w_in = args.in[6]; F.w_conv = args.in[7];
    F.lambda_qk = args.in[8]; F.subln_w = args.in[9]; F.lb_logits = args.in[10]; F.hgrn_norm_w = args.in[11]; F.w_out = args.in[12]; F.ln_w = args.in[13]; F.ln_b = args.in[14];
    F.w_router = args.in[15]; F.w_gate = args.in[16]; F.w_up = args.in[17]; F.w_down = args.in[18];
    volatile LAS unsigned* MISC = (volatile LAS unsigned*)(F.lds + MISC_OFF);
    for (int u = F.tid; u < (LDS_BYTES - RING_BYTES) / 4; u += NWAVES * 64) ((LAS unsigned*)(F.lds + RING_BYTES))[u] = 0u;
    __syncthreads();
    const int lo = args.ph_lo, hi = args.ph_hi;
    const bool one = (hi - lo) > 1;
    XcdBarrier bar; bar.bar = (unsigned*)(F.ws + WS_CTL) + CW_BAR; bar.x = 0; bar.st = nullptr;
    if (one) bar = xcd_barrier_post((unsigned*)(F.ws + WS_CTL) + CW_BAR, MISC + 8);
#ifndef MK_MASK
#define MK_MASK 0xffffffffu
#endif
#define IN(k) (lo <= (k) && (k) < hi)
#define ON(j) ((MK_MASK >> (j)) & 1u)
#ifndef MK_REP
#define MK_REP 0u
#endif
#define NREP(j) (1 + (int)((MK_REP >> (j)) & 1u))
#ifndef MK_BAR2
#define MK_BAR2 0
#endif
#ifndef MK_TSEL
#define MK_TSEL (-1)
#endif
    unsigned long long t_prev = 0ull, t_acc = 0ull;
    if (MK_TSEL >= 0) t_prev = __builtin_amdgcn_s_memrealtime();
#define TSTAMP(j) do { if (MK_TSEL >= 0) { const unsigned long long t_now = __builtin_amdgcn_s_memrealtime(); if (MK_TSEL == (j)) t_acc += t_now - t_prev; t_prev = t_now; } } while (0)
#define SEAM(k) do { if (IN(k) && IN((k) + 1)) { xcd_barrier(bar); if (MK_BAR2) xcd_barrier(bar); } } while (0)
#define RELAUNDER() do { int t_ = threadIdx.x; asm volatile("" : "+v"(t_)); F.tid = t_; F.lane = t_ & 63; F.wave = __builtin_amdgcn_readfirstlane(t_ >> 6); } while (0)

    if (ON(11) && IN(0)) for (int rep_ = 0; rep_ < NREP(11); ++rep_) { RELAUNDER(); p0_prologue(F); } SEAM(0); TSTAMP(11);
    if (ON(12) && IN(1)) for (int rep_ = 0; rep_ < NREP(12); ++rep_) { RELAUNDER(); p1_modulate(F); } SEAM(1); TSTAMP(12);

    for (int l = 0; l < DEPTH; ++l) {
        const int pb = 2 + 11 * l;
        const bool need_ctx = (l + 1 < DEPTH);
        const float* MODL = (const float*)(F.ws + WS_MOD) + (size_t)l * 3 * 12288;
        if (ON(0) && IN(pb + 0)) for (int rep_ = 0; rep_ < NREP(0); ++rep_) { RELAUNDER();
            pg8::Gemm g{(const pg8::bf16_t*)(F.ws + WS_XM), (const pg8::bf16_t*)(F.ws + WS_WIN) + (size_t)l * PROJ_W * DM, MROWS, PROJ_W, DM};
            pg8::StaticOrder S; S.init(MROWS, PROJ_W, F.G, (int)blockIdx.x);
            pg8::EpiProj E{(pg8::bf16_t*)(F.ws + WS_QKV), (pg8::bf16_t*)(F.ws + WS_CG), (float*)(F.ws + WS_GF)};
            pg8::gemm_phase<pg8::EpiProj, pg8::StaticOrder, true, true>(F.lds, g, S, E);
            { const int nu = (MROWS / 256) * (PROJ_W / 256), extra = nu % F.G, bx = (int)blockIdx.x;
              if (extra == 0 || bx >= extra) { RELAUNDER(); deferred_convert(F, l == 0 ? CV_P0E : CV_S4, l == 0 ? CV_S1 : CV_DEFER, extra == 0 ? bx : bx - extra, extra == 0 ? F.G : F.G - extra); } }
        }
        SEAM(pb + 0); TSTAMP(0);
        if (ON(1) && IN(pb + 1)) for (int rep_ = 0; rep_ < NREP(1); ++rep_) { RELAUNDER();
            if (ON(13)) for (int r2_ = 0; r2_ < NREP(13); ++r2_) hg_h1_units(F, l);
            RELAUNDER(); if (ON(14)) for (int r2_ = 0; r2_ < NREP(14); ++r2_) conv_rows(F, l, need_ctx ? MROWS : NLAT);
            RELAUNDER(); if (ON(15)) for (int r2_ = 0; r2_ < NREP(15); ++r2_) {
            const float* lq = F.lambda_qk + (size_t)l * 4 * 64;
            const float s1 = wave_sum(lq[F.lane] * lq[64 + F.lane]), s2 = wave_sum(lq[128 + F.lane] * lq[192 + F.lane]);
            const float li = lambda_init_of(l), lam = expf(s1) - expf(s2) + li, post = 1.0f - li;
            const bf16* Q = (const bf16*)(F.ws + WS_QKV); const bf16* K = Q + (size_t)MROWS * 1024; const bf16* V = K + (size_t)MROWS * 1024;
            bf16* MIX = (bf16*)(F.ws + WS_MIX);
            const int nunits = 1024 + (need_ctx ? 32 : 0);
            __syncthreads();
            for (int i = 0;; ++i) { const int u = i * F.G + F.vcu; if (u >= nunits) break;
                if (u < 1024) { const int bh = u >> 6, qb = u & 63, b = bh >> 3, h = bh & 7; const size_t q0 = (size_t)b * SEQ + qb * 128;
                    att::attn_unit(Q + q0 * 1024 + h * 128, K + h * 128, V + h * 128, b * SEQ, 128, NLAT + b * CTXL, 132, lam, post, F.subln_w + l * 128, MIX + q0 * DM + h * 128, F.ldsg); }
                else { const int uc = u - 1024, bh = uc >> 1, qb = uc & 1, b = bh >> 3, h = bh & 7; const size_t q0 = (size_t)NLAT + b * CTXL + qb * 128;
                    att::attn_unit(Q + q0 * 1024 + h * 128, K + h * 128, V + h * 128, 0, 0, NLAT + b * CTXL, 4, lam, post, F.subln_w + l * 128, MIX + q0 * DM + h * 128, F.ldsg); } }
            }
        }
        SEAM(pb + 1); TSTAMP(1);
        if (ON(2) && IN(pb + 2)) for (int rep_ = 0; rep_ < NREP(2); ++rep_) { RELAUNDER(); hg_h2(F); }
        SEAM(pb + 2); TSTAMP(2);
        if (ON(3) && IN(pb + 3)) for (int rep_ = 0; rep_ < NREP(3); ++rep_) { RELAUNDER();
            unsigned* tick = (unsigned*)(F.ws + WS_CTL) + 8192 + 64 * l; volatile LAS unsigned* tk = (volatile LAS unsigned*)(F.lds + RING_BYTES + 64);
            const int nun = need_ctx ? 8 * NCHUNK : 8 * (NCHUNK - 4);
            for (;;) {
                if (F.tid == 0) *tk = __hip_atomic_fetch_add(tick, 1u, __ATOMIC_RELAXED, __HIP_MEMORY_SCOPE_AGENT);
                __syncthreads();
                const int t = (int)*tk;
                __syncthreads();
                if (t >= nun) break;
                const int u = need_ctx ? t : (t / (NCHUNK - 4)) * NCHUNK + 4 + t % (NCHUNK - 4);
                H3SEG(5);
                hg_h3_unit(F, l, u);
            } }
        SEAM(pb + 3); TSTAMP(3);
        if (ON(4) && IN(pb + 4)) for (int rep_ = 0; rep_ < NREP(4); ++rep_) { RELAUNDER();
            const int M = need_ctx ? MROWS : NLAT;
            pg8::Gemm g{(const pg8::bf16_t*)(F.ws + WS_MIX), (const pg8::bf16_t*)(F.ws + WS_WOUT) + (size_t)l * DM * DM, M, DM, DM};
            pg8::StaticOrder S; S.init(M, DM, F.G, (int)blockIdx.x);
            pg8::EpiOut E{l == 0 ? F.x : (const float*)F.out, l == 0 ? F.ctx : (const float*)(F.ws + WS_R2C), (float*)(F.ws + WS_Z), MODL};
            pg8::gemm_phase<pg8::EpiOut, pg8::StaticOrder, true, true>(F.lds, g, S, E);
            if (l == 0) { const int nu = (M / 256) * (DM / 256), extra = nu % F.G, bx = (int)blockIdx.x;
              if (extra == 0 || bx >= extra) { RELAUNDER(); deferred_convert(F, CV_S1, CV_S2, extra == 0 ? bx : bx - extra, extra == 0 ? F.G : F.G - extra); } }
        }
        SEAM(pb + 4); TSTAMP(4);
        if (ON(5) && IN(pb + 5)) for (int rep_ = 0; rep_ < NREP(5); ++rep_) { RELAUNDER(); ln1_router(F, l, need_ctx ? MROWS : NLAT); }
        SEAM(pb + 5); TSTAMP(5);
        if (ON(6) && IN(pb + 6)) for (int rep_ = 0; rep_ < NREP(6); ++rep_) { RELAUNDER(); for (int u = blockIdx.x; u < (need_ctx ? 64 : 32); u += F.G) topk_unit(F, u);
            if (l == 0) { const int bx = (int)blockIdx.x;
              if (F.G <= 64 || bx >= 64) { __syncthreads(); RELAUNDER(); deferred_inout(F, F.G <= 64 ? bx : bx - 64, F.G <= 64 ? F.G : F.G - 64); } } }
        SEAM(pb + 6); TSTAMP(6);
        if (ON(8) && IN(pb + 8)) for (int rep_ = 0; rep_ < NREP(8); ++rep_) { RELAUNDER();
            pg8::Gemm g{(const pg8::bf16_t*)(F.ws + WS_XM), (const pg8::bf16_t*)(F.ws + WS_WGU) + (size_t)l * NEXP * 2048 * DM, XG_ROWS, NEXP * 2048, DM};
            pg8::MoeOrder S{F.G, (int)blockIdx.x, 1024 + (need_ctx ? 128 : 0)};
            pg8::EpiMoe1 E{(pg8::bf16_t*)(F.ws + WS_HID)};
            pg8::gemm_phase<pg8::EpiMoe1, pg8::MoeOrder, true, true, true>(F.lds, g, S, E, (const int*)(F.ws + WS_ROWSRC));
            if (l == 0) { const int extra = S.ntot % F.G, bx = (int)blockIdx.x;
              if (extra == 0 || bx >= extra) { RELAUNDER(); deferred_convert(F, CV_S2, CV_S3, extra == 0 ? bx : bx - extra, extra == 0 ? F.G : F.G - extra); } }
        }
        SEAM(pb + 8); TSTAMP(8);
        if (ON(9) && IN(pb + 9)) for (int rep_ = 0; rep_ < NREP(9); ++rep_) { RELAUNDER();
            pg8::Gemm g{(const pg8::bf16_t*)(F.ws + WS_HID), (const pg8::bf16_t*)(F.ws + WS_WD) + (size_t)l * NEXP * DM * EFF, XG_ROWS, NEXP * 2048, EFF};
            pg8::MoeOrder S{F.G, (int)blockIdx.x, 1024 + (need_ctx ? 128 : 0)};
            pg8::EpiMoe2 E{(pg8::bf16_t*)(F.ws + WS_Y)};
            pg8::gemm_phase<pg8::EpiMoe2, pg8::MoeOrder, true, true>(F.lds, g, S, E);
            if (l == 0) { const int extra = S.ntot % F.G, bx = (int)blockIdx.x;
              if (extra == 0 || bx >= extra) { RELAUNDER(); deferred_convert(F, CV_S3, CV_S4, extra == 0 ? bx : bx - extra, extra == 0 ? F.G : F.G - extra); } }
        }
        SEAM(pb + 9); TSTAMP(9);
        if (ON(10) && IN(pb + 10)) for (int rep_ = 0; rep_ < NREP(10); ++rep_) { RELAUNDER(); combine_ln2(F, l, need_ctx ? MROWS : NLAT); }
        SEAM(pb + 10); TSTAMP(10);
    }
    if (MK_HSEL >= 0 && blockIdx.x == 0) { __syncthreads(); const unsigned hacc = *(volatile LAS unsigned*)(F.lds + RING_BYTES + 128); const unsigned long long t_end = __builtin_amdgcn_s_memrealtime(); while (__builtin_amdgcn_s_memrealtime() - t_end < (unsigned long long)hacc) __builtin_amdgcn_s_sleep(8); }
    if (MK_TSEL >= 0 && blockIdx.x == 0) { __syncthreads(); const unsigned long long t_end = __builtin_amdgcn_s_memrealtime(); while (__builtin_amdgcn_s_memrealtime() - t_end < t_acc) __builtin_amdgcn_s_sleep(8); }
#undef IN
#undef SEAM
}

extern "C" void kernel_launch(void* const* d_in, const int* in_sizes, int n_in, void* d_out, int out_size, void* d_ws, size_t ws_size, hipStream_t stream) {
    static int grid = 0;
    if (grid == 0) {
        if (n_in != 19 || in_sizes[0] != NLAT * DM || out_size != NLAT * DM || ws_size < WS_END) { fprintf(stderr, "kernel_launch: shape mismatch (n_in %d, in0 %d, out %d, ws %zu, need %zu)\n", n_in, n_in > 0 ? in_sizes[0] : -1, out_size, ws_size, (size_t)WS_END); grid = -1; return; }
        int dev = 0, cus = 0, per_cu = 0;
        if (hipGetDevice(&dev) != hipSuccess || hipDeviceGetAttribute(&cus, hipDeviceAttributeMultiprocessorCount, dev) != hipSuccess) { grid = -1; return; }
        if (hipFuncSetAttribute((const void*)mk_fwd, hipFuncAttributeMaxDynamicSharedMemorySize, LDS_BYTES) != hipSuccess) { fprintf(stderr, "kernel_launch: hipFuncSetAttribute failed\n"); grid = -1; return; }
        if (hipOccupancyMaxActiveBlocksPerMultiprocessor(&per_cu, (const void*)mk_fwd, NWAVES * 64, LDS_BYTES) != hipSuccess || per_cu < 1) fprintf(stderr, "kernel_launch: occupancy query reports %d\n", per_cu);
        (void)hipGetLastError();
        grid = cus;
        if (SEQ % (2 * NWAVES * grid) != 0) { fprintf(stderr, "kernel_launch: the LN1 phase stages per-batch vectors per trip of 2 x %d rows, which must divide the %d rows of a batch (grid %d); nothing launched\n", NWAVES * grid, SEQ, grid); grid = -1; return; }
    }
    if (grid < 0) return;
    (void)hipMemsetAsync((char*)d_ws + WS_CTL, 0, CTL_ZERO_BYTES, stream);
    Args a{};
    for (int i = 0; i < 19; ++i) a.in[i] = (const float*)d_in[i];
    a.out = (float*)d_out; a.ws = (unsigned char*)d_ws;
#if MK_ONE_LAUNCH
    a.ph_lo = 0; a.ph_hi = NPHASE;
    hipLaunchKernelGGL(mk_fwd, dim3(grid), dim3(NWAVES * 64), LDS_BYTES, stream, a);
#else
    for (int p = 0; p < NPHASE; ++p) { a.ph_lo = p; a.ph_hi = p + 1; hipLaunchKernelGGL(mk_fwd, dim3(grid), dim3(NWAVES * 64), LDS_BYTES, stream, a); }
#endif
}
```
